# Optimizing an MI355X kernel written in HIP

```python
import math
import jax, jax.numpy as jnp
from jax import lax
import numpy as np

D_MODEL = 1024
BATCH = 4
SEQ = 4096
DEPTH = 1
DEC_BATCH = 128
DEC_SEQ = 8
PAST_LEN = 8192
PAGE_SIZE = 128

HEAD_DIM = 64
N_GROUPS = 3
WINDOWS = (128, 512, 2048)
DILATIONS = (1, 4, 16)
N_BACK = 128
HEADS_PER_GROUP = D_MODEL // 128
A_HEADS = N_GROUPS * HEADS_PER_GROUP
A_QKV = A_HEADS * HEAD_DIM
A_OUT = HEADS_PER_GROUP * HEAD_DIM
ATTN_BLOCK = 128
ATTN_SCALE = HEAD_DIM ** -0.5
B_HEADS = D_MODEL // 256
B_F_HEAD = 128
B_I_HEAD = D_MODEL // (2 * B_HEADS)
B_F = B_HEADS * B_F_HEAD
B_I = B_HEADS * B_I_HEAD
B_OUT = B_I
CHUNK = 64
IN_COLS = 3 * A_QKV + A_OUT + 2 * B_F + B_I + B_OUT + 2 * D_MODEL
EPS = 1e-6

kernel_name = 'hybrid_dilated_attn_hgrn2_decode_step'


def rmsnorm(x, gain):
    xf = x.astype(jnp.float32)
    y = xf * lax.rsqrt(jnp.mean(xf * xf, axis=-1, keepdims=True) + EPS) * gain.astype(jnp.float32)
    return y.astype(x.dtype)


def alibi_slopes():
    s = 2.0 ** (-8.0 * (np.arange(A_HEADS) + 1) / A_HEADS)
    return jnp.asarray(s.astype(np.float32).reshape(N_GROUPS, HEADS_PER_GROUP))


def dilated_group_prompt(q, k, v, dil, slopes):
    n, t, h, hd = q.shape
    L = t // dil
    nb = -(-L // ATTN_BLOCK)
    lp = nb * ATTN_BLOCK

    def split(a):
        a = a.reshape(n, L, dil, h, hd).transpose(0, 2, 1, 3, 4)
        a = jnp.pad(a, ((0, 0), (0, 0), (0, lp - L), (0, 0), (0, 0)))
        return a.reshape(n, dil, nb, ATTN_BLOCK, h, hd)

    def with_prev(a):
        prev = jnp.pad(a[:, :, :-1], ((0, 0), (0, 0), (1, 0), (0, 0), (0, 0), (0, 0)))
        return jnp.concatenate([prev, a], axis=3)

    qb = split(q)
    kk = with_prev(split(k))
    vv = with_prev(split(v))
    s = jnp.einsum('brnqhd,brnkhd->brnhqk', qb, kk).astype(jnp.float32) * ATTN_SCALE
    delta = np.arange(ATTN_BLOCK)[:, None] + ATTN_BLOCK - np.arange(2 * ATTN_BLOCK)[None, :]
    key_pos = (np.arange(nb)[:, None, None] * ATTN_BLOCK
               + np.arange(2 * ATTN_BLOCK)[None, None, :] - ATTN_BLOCK)
    valid = (delta >= 0) & (delta <= N_BACK) & (key_pos >= 0)
    dist = jnp.asarray((delta * dil).astype(np.float32))
    s = s - slopes[:, None, None] * dist
    s = jnp.where(valid[:, None], s, -jnp.inf)
    m = jnp.max(s, axis=-1, keepdims=True)
    p = jnp.exp(s - m)
    l = jnp.sum(p, axis=-1, keepdims=True)
    o = jnp.einsum('brnhqk,brnkhd->brnqhd', p, vv.astype(jnp.float32)) / jnp.swapaxes(l, 3, 4)
    lse = jnp.swapaxes((m + jnp.log(l))[..., 0], 3, 4)
    o = o.reshape(n, dil, lp, h, hd)[:, :, :L].transpose(0, 2, 1, 3, 4).reshape(n, t, h, hd)
    lse = lse.reshape(n, dil, lp, h)[:, :, :L].transpose(0, 2, 1, 3).reshape(n, t, h)
    return o, lse


def dilated_group_sample(q, k, v, kv_buf, dil, slopes):
    n, t, h, hd = q.shape
    wb = kv_buf.shape[1]
    kcat = jnp.concatenate([kv_buf[:, :, 0], k], axis=1)
    vcat = jnp.concatenate([kv_buf[:, :, 1], v], axis=1)
    steps = np.arange(N_BACK + 1)
    idx = wb + np.arange(t)[:, None] - steps[None, :] * dil
    valid = idx >= 0
    idx = np.maximum(idx, 0)
    kg = kcat[:, idx]
    vg = vcat[:, idx]
    dist = jnp.asarray((steps * dil).astype(np.float32))
    s = jnp.einsum('nthd,ntkhd->nthk', q, kg).astype(jnp.float32) * ATTN_SCALE - slopes[:, None] * dist
    s = jnp.where(valid[:, None, :], s, -jnp.inf)
    m = jnp.max(s, axis=-1, keepdims=True)
    p = jnp.exp(s - m)
    l = jnp.sum(p, axis=-1, keepdims=True)
    o = jnp.einsum('nthk,ntkhd->nthd', p, vg.astype(jnp.float32)) / l
    lse = (m + jnp.log(l))[..., 0]
    return o, lse


def hgrn2_recurrence(q, k, v, log_f, s0):
    n, t, h, fd = q.shape
    iv = v.shape[-1]
    c = min(CHUNK, t)
    nc = -(-t // c)
    tp = nc * c

    def chunks(a):
        a = jnp.pad(a, ((0, 0), (0, tp - t), (0, 0), (0, 0)))
        return jnp.moveaxis(a.reshape(n, nc, c, h, a.shape[-1]), 1, 0)

    causal = np.tril(np.ones((c, c), dtype=bool))[None, :, :, None, None]

    def step(state, inp):
        qc, kc, vc, gc = inp
        b = jnp.cumsum(gc, axis=1)
        o_inter = jnp.einsum('nchf,nhfi->nchi', qc * jnp.exp(b), state)
        decay = jnp.exp(jnp.where(causal, b[:, :, None] - b[:, None, :], -jnp.inf))
        att = jnp.einsum('nthf,nshf,ntshf->nths', qc, kc, decay)
        o_intra = jnp.einsum('nths,nshi->nthi', att, vc)
        b_last = b[:, -1]
        state = (jnp.exp(b_last)[..., None] * state
                 + jnp.einsum('nshf,nshi->nhfi', kc * jnp.exp(b_last[:, None] - b), vc))
        return state, o_inter + o_intra

    s_fin, o = lax.scan(step, s0.astype(jnp.float32),
                        (chunks(q), chunks(k), chunks(v), chunks(log_f)))
    o = jnp.moveaxis(o, 0, 1).reshape(n, tp, h, iv)[:, :t]
    return o, s_fin


def mixer_layer(x, c, kv_bufs, hgrn_state, lb, norm_gain, w_ada, b_ada, w_in, q_gain, k_gain,
                o_gain, w_ba, w_bb, w_o):
    n, t, _ = x.shape
    shift, scale, gate = jnp.split(jax.nn.silu(c) @ w_ada + b_ada, 3, axis=-1)
    h = rmsnorm(x, norm_gain) * (1 + scale[:, None]) + shift[:, None]
    sizes = (A_QKV, A_QKV, A_QKV, A_OUT, B_F, B_F, B_I, B_OUT, D_MODEL, D_MODEL)
    cuts = np.cumsum(sizes)[:-1].tolist()
    qa, ka, va, za, qb, fb, ib, zb, ga, gb = jnp.split(h @ w_in, cuts, axis=-1)

    shp = (n, t, N_GROUPS, HEADS_PER_GROUP, HEAD_DIM)
    qa = rmsnorm(qa.reshape(shp), q_gain)
    ka = rmsnorm(ka.reshape(shp), k_gain)
    va = va.reshape(shp)
    slopes = alibi_slopes()
    outs, lses, new_kv = [], [], []
    for g in range(N_GROUPS):
        qg, kg, vg = qa[:, :, g], ka[:, :, g], va[:, :, g]
        kv_rows = jnp.stack([kg, vg], axis=2)
        if kv_bufs is None:
            o, lse = dilated_group_prompt(qg, kg, vg, DILATIONS[g], slopes[g])
            kv_rows = kv_rows[:, t - min(WINDOWS[g], t):]
        else:
            o, lse = dilated_group_sample(qg, kg, vg, kv_bufs[g], DILATIONS[g], slopes[g])
        outs.append(o)
        lses.append(lse)
        new_kv.append(kv_rows)
    alpha = jax.nn.softmax(jnp.stack(lses), axis=0)
    o_a = jnp.einsum('gnth,gnthd->nthd', alpha, jnp.stack(outs)).reshape(n, t, A_OUT).astype(x.dtype)
    branch_a = (o_a * jax.nn.silu(za)) @ w_ba

    lbh = lb.reshape(B_HEADS, B_F_HEAD)
    f = lbh + (1.0 - lbh) * jax.nn.sigmoid(fb.astype(jnp.float32).reshape(n, t, B_HEADS, B_F_HEAD))
    q_h = jax.nn.silu(qb.astype(jnp.float32)).reshape(n, t, B_HEADS, B_F_HEAD)
    i_h = ib.astype(jnp.float32).reshape(n, t, B_HEADS, B_I_HEAD)
    o_b, s_new = hgrn2_recurrence(q_h, 1.0 - f, i_h, jnp.log(f), hgrn_state)
    o_b = rmsnorm(o_b, o_gain).reshape(n, t, B_OUT).astype(x.dtype)
    branch_b = (o_b * jax.nn.silu(zb)) @ w_bb

    merged = jax.nn.sigmoid(ga) * branch_a + jax.nn.sigmoid(gb) * branch_b
    y = x + gate[:, None] * (merged @ w_o)
    return y, new_kv, s_new.astype(x.dtype)


def setup_inputs(seed: int = 0) -> dict:
    key = jax.random.key(seed)
    ks = jax.random.split(key, 20)

    def nrm(k, shape, s):
        return jax.random.normal(k, shape, jnp.float32) * s

    kv_shape = lambda g: (DEPTH, DEC_BATCH, min(WINDOWS[g], PAST_LEN), 2, HEADS_PER_GROUP, HEAD_DIM)
    return {
        'x_prompt': nrm(ks[0], (BATCH, SEQ, D_MODEL), 1.0),
        'x_sample': nrm(ks[1], (DEC_BATCH, DEC_SEQ, D_MODEL), 1.0),
        'cache_kv_g0': nrm(ks[2], kv_shape(0), 1.0),
        'cache_kv_g1': nrm(ks[3], kv_shape(1), 1.0),
        'cache_kv_g2': nrm(ks[4], kv_shape(2), 1.0),
        'state_hgrn': nrm(ks[5], (DEPTH, DEC_BATCH, B_HEADS, B_F_HEAD, B_I_HEAD), 0.3),
        'c_prompt': nrm(ks[6], (BATCH, D_MODEL), 1.0),
        'c_sample': nrm(ks[7], (DEC_BATCH, D_MODEL), 1.0),
        'norm_gain': 1.0 + nrm(ks[8], (DEPTH, D_MODEL), 0.1),
        'w_ada': nrm(ks[9], (DEPTH, D_MODEL, 3 * D_MODEL), 0.5 * D_MODEL ** -0.5),
        'b_ada': nrm(ks[10], (DEPTH, 3 * D_MODEL), 0.01),
        'w_in': nrm(ks[11], (DEPTH, D_MODEL, IN_COLS), D_MODEL ** -0.5),
        'q_norm_gain': 1.0 + nrm(ks[12], (DEPTH, HEAD_DIM), 0.1),
        'k_norm_gain': 1.0 + nrm(ks[13], (DEPTH, HEAD_DIM), 0.1),
        'hgrn_lb_logits': nrm(ks[14], (DEPTH + 1, B_F), 0.5),
        'hgrn_out_norm_gain': 1.0 + nrm(ks[15], (DEPTH, B_I_HEAD), 0.1),
        'w_branch_a': nrm(ks[16], (DEPTH, A_OUT, D_MODEL), A_OUT ** -0.5),
        'w_branch_b': nrm(ks[17], (DEPTH, B_OUT, D_MODEL), B_OUT ** -0.5),
        'w_out': nrm(ks[18], (DEPTH, D_MODEL, D_MODEL), D_MODEL ** -0.5),
    }


def reference(x_prompt, x_sample, cache_kv_g0, cache_kv_g1, cache_kv_g2, state_hgrn, c_prompt, c_sample,
              norm_gain, w_ada, b_ada, w_in, q_norm_gain, k_norm_gain, hgrn_lb_logits, hgrn_out_norm_gain,
              w_branch_a, w_branch_b, w_out):
    lbs = jnp.cumsum(jax.nn.softmax(hgrn_lb_logits.astype(jnp.float32), axis=0), axis=0)
    xp, xs = x_prompt, x_sample
    kvp = ([], [], [])
    kvs = ([], [], [])
    sp, ss = [], []
    for layer in range(DEPTH):
        w = (norm_gain[layer], w_ada[layer], b_ada[layer], w_in[layer], q_norm_gain[layer],
             k_norm_gain[layer], hgrn_out_norm_gain[layer], w_branch_a[layer], w_branch_b[layer], w_out[layer])
        s0 = jnp.zeros((xp.shape[0], B_HEADS, B_F_HEAD, B_I_HEAD), jnp.float32)
        xp, kv_new, s_new = mixer_layer(xp, c_prompt, None, s0, lbs[layer], *w)
        for g in range(N_GROUPS):
            kvp[g].append(kv_new[g])
        sp.append(s_new)
        bufs = (cache_kv_g0[layer], cache_kv_g1[layer], cache_kv_g2[layer])
        xs, kv_new, s_new = mixer_layer(xs, c_sample, bufs, state_hgrn[layer], lbs[layer], *w)
        for g in range(N_GROUPS):
            kvs[g].append(kv_new[g])
        ss.append(s_new)
    return (xp, xs,
            jnp.stack(kvp[0]), jnp.stack(kvp[1]), jnp.stack(kvp[2]), jnp.stack(sp),
            jnp.stack(kvs[0]), jnp.stack(kvs[1]), jnp.stack(kvs[2]), jnp.stack(ss))
```

```cpp
#include <hip/hip_runtime.h>
#include <cstdio>
#include <cstdint>

constexpr int D = 1024, NP = 4, TP = 4096, NS = 128, TS = 8;
constexpr int MP = NP * TP, MS = NS * TS, M = MP + MS;
constexpr int NIN = 9216;
constexpr int C_QA = 0, C_KA = 1536, C_VA = 3072, C_ZA = 4608, C_QB = 5120, C_FB = 5632, C_IB = 6144, C_ZB = 6656, C_GA = 7168, C_GB = 8192;
constexpr int NSEQ = NP + NS;
constexpr float EPS = 1e-6f;
constexpr int NTHR = 512, NWAVES = 8;

constexpr size_t O_YP = 0, O_YS = O_YP + (size_t)MP * D, O_KVP0 = O_YS + (size_t)MS * D, O_KVP1 = O_KVP0 + (size_t)NP * 128 * 1024,
                 O_KVP2 = O_KVP1 + (size_t)NP * 512 * 1024, O_HP = O_KVP2 + (size_t)NP * 2048 * 1024, O_KVS0 = O_HP + (size_t)NP * 4 * 128 * 128,
                 O_KVS1 = O_KVS0 + (size_t)MS * 1024, O_KVS2 = O_KVS1 + (size_t)MS * 1024, O_HS = O_KVS2 + (size_t)MS * 1024, O_END = O_HS + (size_t)NS * 4 * 128 * 128;

constexpr size_t MiB = 1u << 20;
constexpr size_t WS_CTL = 0;
constexpr size_t WS_ADA = 1 * MiB;
constexpr size_t WS_LB = 3 * MiB;
constexpr size_t WS_H = 4 * MiB;
constexpr size_t WS_U = 80 * MiB;
constexpr size_t WS_OA = 700 * MiB;
constexpr size_t WS_OB = 740 * MiB;
constexpr size_t WS_MG = 780 * MiB;
constexpr size_t WS_END = 860 * MiB;

struct Args {
    const float* in[19]; float* out; unsigned char* ws; int ph_lo, ph_hi;
};

__device__ __forceinline__ float wave_sum(float v) {
#pragma unroll
    for (int o = 1; o < 64; o <<= 1) v += __shfl_xor(v, o);
    return v;
}
__device__ __forceinline__ float wave_max(float v) {
#pragma unroll
    for (int o = 1; o < 64; o <<= 1) v = fmaxf(v, __shfl_xor(v, o));
    return v;
}
__device__ __forceinline__ float sigmoidf_(float x) { return 1.0f / (1.0f + expf(-x)); }
__device__ __forceinline__ float siluf_(float x) { return x / (1.0f + expf(-x)); }
__device__ __forceinline__ int seq_of_row(int r) { return r < MP ? r / TP : NP + (r - MP) / TS; }

template <class Epi>
__device__ __forceinline__ void gemm_f32(float* lds, const float* A, int lda, const float* B, int ldb, int Mr, int Nc, int K, const Epi& E) {
    float* As = lds;
    float* Bs = lds + 16 * 132;
    const int tid = threadIdx.x, tx = tid & 31, ty = tid >> 5;
    const int ntm = Mr / 128, ntn = Nc / 128, ntiles = ntm * ntn;
    for (int tile = blockIdx.x; tile < ntiles; tile += gridDim.x) {
        const int tm = tile / ntn, tn = tile % ntn;
        const int row0 = tm * 128, col0 = tn * 128;
        float acc[8][4];
#pragma unroll
        for (int i = 0; i < 8; ++i)
#pragma unroll
            for (int j = 0; j < 4; ++j) acc[i][j] = 0.f;
        for (int k0 = 0; k0 < K; k0 += 16) {
            {
                const int r = tid >> 2, kq = (tid & 3) * 4;
                const float4 a = *(const float4*)(A + (size_t)(row0 + r) * lda + k0 + kq);
                As[(kq + 0) * 132 + r] = a.x; As[(kq + 1) * 132 + r] = a.y; As[(kq + 2) * 132 + r] = a.z; As[(kq + 3) * 132 + r] = a.w;
                const int kb = tid >> 5, c4 = (tid & 31) * 4;
                const float4 b = *(const float4*)(B + (size_t)(k0 + kb) * ldb + col0 + c4);
                *(float4*)(Bs + kb * 128 + c4) = b;
            }
            __syncthreads();
#pragma unroll
            for (int kk = 0; kk < 16; ++kk) {
                const float4 a0 = *(const float4*)(As + kk * 132 + ty * 8);
                const float4 a1 = *(const float4*)(As + kk * 132 + ty * 8 + 4);
                const float4 b = *(const float4*)(Bs + kk * 128 + tx * 4);
                const float av[8] = {a0.x, a0.y, a0.z, a0.w, a1.x, a1.y, a1.z, a1.w};
                const float bv[4] = {b.x, b.y, b.z, b.w};
#pragma unroll
                for (int i = 0; i < 8; ++i)
#pragma unroll
                    for (int j = 0; j < 4; ++j) acc[i][j] = fmaf(av[i], bv[j], acc[i][j]);
            }
            __syncthreads();
        }
#pragma unroll
        for (int i = 0; i < 8; ++i) E(row0 + ty * 8 + i, col0 + tx * 4, acc[i]);
    }
}

struct EpiStore { float* C; int ldc; __device__ __forceinline__ void operator()(int r, int c, const float (&v)[4]) const { *(float4*)(C + (size_t)r * ldc + c) = make_float4(v[0], v[1], v[2], v[3]); } };
struct EpiGateA { float* C; const float* U; __device__ __forceinline__ void operator()(int r, int c, const float (&v)[4]) const {
    const float4 g = *(const float4*)(U + (size_t)r * NIN + C_GA + c);
    *(float4*)(C + (size_t)r * D + c) = make_float4(sigmoidf_(g.x) * v[0], sigmoidf_(g.y) * v[1], sigmoidf_(g.z) * v[2], sigmoidf_(g.w) * v[3]); } };
struct EpiGateB { float* C; const float* U; __device__ __forceinline__ void operator()(int r, int c, const float (&v)[4]) const {
    const float4 g = *(const float4*)(U + (size_t)r * NIN + C_GB + c);
    float4 o = *(const float4*)(C + (size_t)r * D + c);
    o.x += sigmoidf_(g.x) * v[0]; o.y += sigmoidf_(g.y) * v[1]; o.z += sigmoidf_(g.z) * v[2]; o.w += sigmoidf_(g.w) * v[3];
    *(float4*)(C + (size_t)r * D + c) = o; } };
struct EpiOut { float* out; const float* xp; const float* xs; const float* ada; __device__ __forceinline__ void operator()(int r, int c, const float (&v)[4]) const {
    const int sq = seq_of_row(r);
    const float4 g = *(const float4*)(ada + (size_t)sq * 3072 + 2048 + c);
    const float* xr = r < MP ? xp + (size_t)r * D : xs + (size_t)(r - MP) * D;
    const float4 x = *(const float4*)(xr + c);
    float* o = out + (r < MP ? O_YP + (size_t)r * D : O_YS + (size_t)(r - MP) * D);
    *(float4*)(o + c) = make_float4(x.x + g.x * v[0], x.y + g.y * v[1], x.z + g.z * v[2], x.w + g.w * v[3]); } };

__global__ void __launch_bounds__(NTHR, 2) fwd(Args a) {
    extern __shared__ __attribute__((aligned(16))) unsigned char lds_raw[];
    float* lds = (float*)lds_raw;
    const int tid = threadIdx.x, lane = tid & 63, wave = tid >> 6;
    const int gw = blockIdx.x * NWAVES + wave, NGW = gridDim.x * NWAVES;
    const float* x_p = a.in[0]; const float* x_s = a.in[1];
    const float* cache[3] = {a.in[2], a.in[3], a.in[4]};
    const float* state_in = a.in[5]; const float* c_p = a.in[6]; const float* c_s = a.in[7];
    const float* norm_gain = a.in[8]; const float* w_ada = a.in[9]; const float* b_ada = a.in[10]; const float* w_in = a.in[11];
    const float* q_gain = a.in[12]; const float* k_gain = a.in[13]; const float* lb_logits = a.in[14]; const float* o_gain = a.in[15];
    const float* w_ba = a.in[16]; const float* w_bb = a.in[17]; const float* w_out = a.in[18];
    float* out = a.out;
    float* ADA = (float*)(a.ws + WS_ADA); float* LB = (float*)(a.ws + WS_LB); float* H = (float*)(a.ws + WS_H); float* U = (float*)(a.ws + WS_U);
    float* OA = (float*)(a.ws + WS_OA); float* OB = (float*)(a.ws + WS_OB); float* MG = (float*)(a.ws + WS_MG);
    const int lo = a.ph_lo, hi = a.ph_hi;
#define IN(k) (lo <= (k) && (k) < hi)

    if (IN(0)) {
        for (int it = blockIdx.x; it < NSEQ * 6; it += gridDim.x) {
            const int sq = it / 6, ch = it % 6;
            const float* c = sq < NP ? c_p + (size_t)sq * D : c_s + (size_t)(sq - NP) * D;
            __syncthreads();
            for (int k = tid; k < D; k += NTHR) lds[k] = siluf_(c[k]);
            __syncthreads();
            const int col = ch * 512 + tid;
            float acc = b_ada[col];
            for (int k = 0; k < D; ++k) acc = fmaf(lds[k], w_ada[(size_t)k * 3072 + col], acc);
            ADA[(size_t)sq * 3072 + col] = acc;
        }
        if (blockIdx.x == 0) {
            const float l0 = lb_logits[tid], l1 = lb_logits[512 + tid];
            const float mx = fmaxf(l0, l1); const float e0 = expf(l0 - mx), e1 = expf(l1 - mx);
            LB[tid] = e0 / (e0 + e1);
        }
    }
    if (IN(1)) {
        for (int r = gw; r < M; r += NGW) {
            const float* xr = r < MP ? x_p + (size_t)r * D : x_s + (size_t)(r - MP) * D;
            const int sq = seq_of_row(r);
            float4 v[4]; float ss = 0.f;
#pragma unroll
            for (int j = 0; j < 4; ++j) { v[j] = *(const float4*)(xr + 256 * j + 4 * lane); ss += v[j].x * v[j].x + v[j].y * v[j].y + v[j].z * v[j].z + v[j].w * v[j].w; }
            const float rstd = 1.0f / sqrtf(wave_sum(ss) * (1.0f / D) + EPS);
#pragma unroll
            for (int j = 0; j < 4; ++j) {
                const int c = 256 * j + 4 * lane;
                const float4 g = *(const float4*)(norm_gain + c), sh = *(const float4*)(ADA + (size_t)sq * 3072 + c), sc = *(const float4*)(ADA + (size_t)sq * 3072 + 1024 + c);
                float4 o; o.x = v[j].x * rstd * g.x * (1.f + sc.x) + sh.x; o.y = v[j].y * rstd * g.y * (1.f + sc.y) + sh.y;
                o.z = v[j].z * rstd * g.z * (1.f + sc.z) + sh.z; o.w = v[j].w * rstd * g.w * (1.f + sc.w) + sh.w;
                *(float4*)(H + (size_t)r * D + c) = o;
            }
        }
    }
    if (IN(2)) { EpiStore E{U, NIN}; gemm_f32(lds, H, D, w_in, NIN, M, NIN, D, E); }
    if (IN(3)) {
        for (int r = gw; r < M; r += NGW) {
            float* ur = U + (size_t)r * NIN;
            const bool prompt = r < MP; const int n = prompt ? r / TP : (r - MP) / TS, t = prompt ? r % TP : (r - MP) % TS;
            for (int hd = 0; hd < 48; ++hd) {
                const float v = ur[hd * 64 + lane];
                const float ss = wave_sum(v * v);
                const float gn = hd < 24 ? q_gain[lane] : k_gain[lane];
                ur[hd * 64 + lane] = v * (1.0f / sqrtf(ss * (1.0f / 64.f) + EPS)) * gn;
            }
            for (int g = 0; g < 3; ++g) {
                const int W = g == 0 ? 128 : (g == 1 ? 512 : 2048);
                float* dst;
                if (prompt) { if (t < TP - W) continue; dst = out + (g == 0 ? O_KVP0 : (g == 1 ? O_KVP1 : O_KVP2)) + ((size_t)n * W + (t - (TP - W))) * 1024; }
                else dst = out + (g == 0 ? O_KVS0 : (g == 1 ? O_KVS1 : O_KVS2)) + ((size_t)n * TS + t) * 1024;
                for (int j = 0; j < 8; ++j) { dst[j * 64 + lane] = ur[C_KA + g * 512 + j * 64 + lane]; dst[512 + j * 64 + lane] = ur[C_VA + g * 512 + j * 64 + lane]; }
            }
            for (int c = lane; c < 512; c += 64) {
                ur[C_QB + c] = siluf_(ur[C_QB + c]);
                const float lb = LB[c];
                ur[C_FB + c] = lb + (1.f - lb) * sigmoidf_(ur[C_FB + c]);
            }
        }
    }
    if (IN(4)) {
        {
            const int c = lane >> 2, qt = lane & 3;
            for (int it = wave * gridDim.x + blockIdx.x; it < NSEQ * 4 * 8; it += NGW) {
                const int sq = it / 32, h = (it / 8) % 4, cg = it % 8;
                const bool prompt = sq < NP;
                const int T = prompt ? TP : TS; const int row0 = prompt ? sq * TP : MP + (sq - NP) * TS;
                const int icol = cg * 16 + c;
                float S[32];
                if (prompt) {
#pragma unroll
                    for (int ff = 0; ff < 32; ++ff) S[ff] = 0.f;
                } else {
                    const float* s0 = state_in + (((size_t)(sq - NP) * 4 + h) * 128) * 128;
#pragma unroll
                    for (int ff = 0; ff < 32; ++ff) S[ff] = s0[(size_t)(qt * 32 + ff) * 128 + icol];
                }
                for (int t = 0; t < T; ++t) {
                    const float* ur = U + (size_t)(row0 + t) * NIN;
                    const float vi = ur[C_IB + h * 128 + icol];
                    float part = 0.f;
#pragma unroll
                    for (int f4 = 0; f4 < 8; ++f4) {
                        const float4 q = *(const float4*)(ur + C_QB + h * 128 + qt * 32 + f4 * 4);
                        const float4 f = *(const float4*)(ur + C_FB + h * 128 + qt * 32 + f4 * 4);
                        S[f4 * 4 + 0] = f.x * S[f4 * 4 + 0] + (1.f - f.x) * vi; part = fmaf(q.x, S[f4 * 4 + 0], part);
                        S[f4 * 4 + 1] = f.y * S[f4 * 4 + 1] + (1.f - f.y) * vi; part = fmaf(q.y, S[f4 * 4 + 1], part);
                        S[f4 * 4 + 2] = f.z * S[f4 * 4 + 2] + (1.f - f.z) * vi; part = fmaf(q.z, S[f4 * 4 + 2], part);
                        S[f4 * 4 + 3] = f.w * S[f4 * 4 + 3] + (1.f - f.w) * vi; part = fmaf(q.w, S[f4 * 4 + 3], part);
                    }
                    part += __shfl_xor(part, 1); part += __shfl_xor(part, 2);
                    if (qt == 0) OB[(size_t)(row0 + t) * 512 + h * 128 + icol] = part;
                }
                float* so = prompt ? out + O_HP + (((size_t)sq * 4 + h) * 128) * 128 : out + O_HS + (((size_t)(sq - NP) * 4 + h) * 128) * 128;
#pragma unroll
                for (int ff = 0; ff < 32; ++ff) so[(size_t)(qt * 32 + ff) * 128 + icol] = S[ff];
            }
        }
        {
            float* qs = lds + wave * 1024;
            float* ps = qs + 192;
            for (int it = gw; it < M * 8; it += NGW) {
                const int r = it >> 3, j = it & 7;
                const bool prompt = r < MP; const int n = prompt ? r / TP : (r - MP) / TS, t = prompt ? r % TP : (r - MP) % TS;
                const float* ur = U + (size_t)r * NIN;
                for (int g = 0; g < 3; ++g) qs[g * 64 + lane] = ur[C_QA + g * 512 + j * 64 + lane];
                __builtin_amdgcn_s_waitcnt(0);
                __builtin_amdgcn_wave_barrier();
                float sc[3][3]; float mx = -INFINITY;
                for (int g = 0; g < 3; ++g) {
                    const int dil = g == 0 ? 1 : (g == 1 ? 4 : 16), wb = g == 0 ? 128 : (g == 1 ? 512 : 2048);
                    const float slope = exp2f(-8.0f * (float)(g * 8 + j + 1) / 24.0f);
                    for (int ch = 0; ch < 3; ++ch) {
                        const int s = ch * 64 + lane;
                        float v = -INFINITY;
                        if (s <= 128) {
                            const float* kp = nullptr;
                            if (prompt) { const int tk = t - s * dil; if (tk >= 0) kp = U + (size_t)(n * TP + tk) * NIN + C_KA + g * 512 + j * 64; }
                            else { const int idx = wb + t - s * dil;
                                if (idx >= wb) kp = U + (size_t)(MP + n * TS + idx - wb) * NIN + C_KA + g * 512 + j * 64;
                                else if (idx >= 0) kp = cache[g] + (((size_t)n * wb + idx) * 2 + 0) * 512 + j * 64; }
                            if (kp) {
                                float d = 0.f;
#pragma unroll
                                for (int q4 = 0; q4 < 16; ++q4) { const float4 kk = *(const float4*)(kp + q4 * 4); const float4 qq = *(const float4*)(qs + g * 64 + q4 * 4);
                                    d = fmaf(qq.x, kk.x, d); d = fmaf(qq.y, kk.y, d); d = fmaf(qq.z, kk.z, d); d = fmaf(qq.w, kk.w, d); }
                                v = d * 0.125f - slope * (float)(s * dil);
                            }
                        }
                        sc[g][ch] = v; mx = fmaxf(mx, v);
                    }
                }
                mx = wave_max(mx);
                float l = 0.f;
                for (int g = 0; g < 3; ++g)
                    for (int ch = 0; ch < 3; ++ch) { const float p = expf(sc[g][ch] - mx); l += p; const int s = ch * 64 + lane; if (s < 192) ps[g * 192 + s] = p; }
                l = wave_sum(l);
                __builtin_amdgcn_s_waitcnt(0);
                __builtin_amdgcn_wave_barrier();
                float o = 0.f;
                for (int g = 0; g < 3; ++g) {
                    const int dil = g == 0 ? 1 : (g == 1 ? 4 : 16), wb = g == 0 ? 128 : (g == 1 ? 512 : 2048);
                    for (int s = 0; s <= 128; ++s) {
                        const float* vp;
                        if (prompt) { const int tk = t - s * dil; if (tk < 0) break; vp = U + (size_t)(n * TP + tk) * NIN + C_VA + g * 512 + j * 64; }
                        else { const int idx = wb + t - s * dil; if (idx < 0) break;
                            vp = idx >= wb ? U + (size_t)(MP + n * TS + idx - wb) * NIN + C_VA + g * 512 + j * 64 : cache[g] + (((size_t)n * wb + idx) * 2 + 1) * 512 + j * 64; }
                        o = fmaf(ps[g * 192 + s], vp[lane], o);
                    }
                }
                OA[(size_t)r * 512 + j * 64 + lane] = (o / l) * siluf_(ur[C_ZA + j * 64 + lane]);
                __builtin_amdgcn_wave_barrier();
            }
        }
    }
    if (IN(5)) {
        for (int it = gw; it < M * 4; it += NGW) {
            const int r = it >> 2, h = it & 3;
            float* ob = OB + (size_t)r * 512 + h * 128; const float* zb = U + (size_t)r * NIN + C_ZB + h * 128;
            const float v0 = ob[lane], v1 = ob[64 + lane];
            const float rstd = 1.0f / sqrtf(wave_sum(v0 * v0 + v1 * v1) * (1.0f / 128.f) + EPS);
            ob[lane] = v0 * rstd * o_gain[lane] * siluf_(zb[lane]);
            ob[64 + lane] = v1 * rstd * o_gain[64 + lane] * siluf_(zb[64 + lane]);
        }
    }
    if (IN(6)) {
        { EpiGateA E{MG, U}; gemm_f32(lds, OA, 512, w_ba, D, M, D, 512, E); }
        { EpiGateB E{MG, U}; gemm_f32(lds, OB, 512, w_bb, D, M, D, 512, E); }
    }
    if (IN(7)) { EpiOut E{out, x_p, x_s, ADA}; gemm_f32(lds, MG, D, w_out, D, M, D, D, E); }
#undef IN
}

extern "C" void kernel_launch(void* const* d_in, const int* in_sizes, int n_in, void* d_out, int out_size, void* d_ws, size_t ws_size, hipStream_t stream) {
    if (n_in != 19 || (size_t)out_size != O_END || ws_size < WS_END) { fprintf(stderr, "kernel_launch: unexpected shapes (n_in %d out %d ws %zu)\n", n_in, out_size, ws_size); return; }
    Args a{};
    for (int i = 0; i < 19; ++i) a.in[i] = (const float*)d_in[i];
    a.out = (float*)d_out; a.ws = (unsigned char*)d_ws;
    constexpr int LDS_BYTES = 32768;
    for (int ph = 0; ph < 8; ++ph) {
        a.ph_lo = ph; a.ph_hi = ph + 1;
        hipLaunchKernelGGL(fwd, dim3(512), dim3(NTHR), LDS_BYTES, stream, a);
    }
}
```

```cpp
#include <hip/hip_runtime.h>
#include <cstdio>
#include <cstdint>

constexpr int D = 1024, NP = 4, TP = 4096, NS = 128, TS = 8;
constexpr int MP = NP * TP, MS = NS * TS, M = MP + MS;
constexpr int NIN = 9216;
constexpr int C_QA = 0, C_KA = 1536, C_VA = 3072, C_ZA = 4608, C_QB = 5120, C_FB = 5632, C_IB = 6144, C_ZB = 6656, C_GA = 7168, C_GB = 8192;
constexpr int NSEQ = NP + NS;
constexpr float EPS = 1e-6f;
constexpr int NTHR = 512, NWAVES = 8;

constexpr size_t O_YP = 0, O_YS = O_YP + (size_t)MP * D, O_KVP0 = O_YS + (size_t)MS * D, O_KVP1 = O_KVP0 + (size_t)NP * 128 * 1024,
                 O_KVP2 = O_KVP1 + (size_t)NP * 512 * 1024, O_HP = O_KVP2 + (size_t)NP * 2048 * 1024, O_KVS0 = O_HP + (size_t)NP * 4 * 128 * 128,
                 O_KVS1 = O_KVS0 + (size_t)MS * 1024, O_KVS2 = O_KVS1 + (size_t)MS * 1024, O_HS = O_KVS2 + (size_t)MS * 1024, O_END = O_HS + (size_t)NS * 4 * 128 * 128;

constexpr size_t MiB = 1u << 20;
constexpr size_t WS_CTL = 0, CTL_ZERO_BYTES = 1 * MiB;
constexpr size_t WS_ADA = 1 * MiB;
constexpr size_t WS_LB = 3 * MiB;
constexpr size_t WS_W1T = 4 * MiB;
constexpr size_t WS_WAT = 22 * MiB;
constexpr size_t WS_WBT = 23 * MiB;
constexpr size_t WS_WOT = 24 * MiB;
constexpr size_t WS_H = 26 * MiB;
constexpr size_t WS_U = 80 * MiB;
constexpr size_t WS_OA = 700 * MiB;
constexpr size_t WS_OB = 720 * MiB;
constexpr size_t WS_OBR = 740 * MiB;
constexpr size_t WS_MGF = 780 * MiB;
constexpr size_t WS_MG = 850 * MiB;
constexpr size_t WS_END = 890 * MiB;
constexpr int CW_BAR = 4096;

constexpr int RING_BYTES = 131072, MISC_OFF = RING_BYTES + 320, LDS_BYTES = 147456;

#define GAS __attribute__((address_space(1)))
#define LAS __attribute__((address_space(3)))
typedef unsigned short bf16;
typedef unsigned v4u __attribute__((ext_vector_type(4)));
typedef unsigned v2u __attribute__((ext_vector_type(2)));

namespace pg8 {
#define PG8_LAS __attribute__((address_space(3)))
typedef unsigned short bf16_t;
typedef short bf16x8 __attribute__((ext_vector_type(8)));
typedef float f32x4 __attribute__((ext_vector_type(4)));
typedef unsigned u32x4 __attribute__((ext_vector_type(4)));
constexpr int BM = 256, BK = 64, HALF = 128, HTB = HALF * BK * 2  , STAGE_BYTES = 8 * HTB, NXCD = 8, WGM = 8;

__host__ __device__ __forceinline__ int lds_byte(int r, int c) { const int st = (r >> 4) * 2 + (c >> 5), rr = r & 15, cc = c & 31, ob = rr * 64 + cc * 2; return st * 1024 + (ob ^ (((ob >> 9) & 1) << 5)); }
__host__ __device__ __forceinline__ void stage_rc(int b, int& R, int& C) { const int st = b / 1024, sb = b % 1024, swz = sb ^ (((sb >> 9) & 1) << 5); R = (st >> 1) * 16 + swz / 64; C = (st & 1) * 32 + (swz % 64) / 2; }
__host__ __device__ __forceinline__ int perm32(int rho) { const int n = rho >> 4, i = rho & 15; return 8 * (i >> 2) + 4 * n + (i & 3); }

struct Unit { int pm, pn; };
struct Gemm { const bf16_t* A; const bf16_t* Bt; int M, N, K; };

struct StaticOrder {
    int nM, nN, nwg, G, c;
    __host__ __device__ void init(int M, int N, int G_, int c_) { nM = M / BM; nN = N / BM; nwg = nM * nN; G = G_; c = c_; }
    __host__ __device__ bool next(int i, Unit& u) const {
        const long L = (long)i * G + c; if (L >= nwg) return false;
        int wgid = (int)L; { const int q = nwg / NXCD, r = nwg % NXCD, xcd = wgid % NXCD, off = wgid / NXCD; wgid = (xcd < r ? xcd * (q + 1) : r * (q + 1) + (xcd - r) * q) + off; }
        const int nig = WGM * nN, gid = wgid / nig, fm = gid * WGM, gsz = (nM - fm) < WGM ? (nM - fm) : WGM;
        u.pm = fm + ((wgid % nig) % gsz); u.pn = (wgid % nig) / gsz; return true;
    }
    __device__ __forceinline__ void a_ready(const Unit&) const {}
    __device__ __forceinline__ void done(const Unit&) const {}
};

__device__ __forceinline__ unsigned cvt_pk_bf16(float lo, float hi) { unsigned r; asm volatile("v_cvt_pk_bf16_f32 %0, %1, %2" : "=v"(r) : "v"(lo), "v"(hi)); return r; }
template <class Epi, class Sched, bool ALIGN_EPI = false, bool SP2 = false>
__device__ __forceinline__ void gemm_phase(PG8_LAS unsigned char* lds, const Gemm g, const Sched& S, const Epi& E) {
    const int tid = threadIdx.x, wid = __builtin_amdgcn_readfirstlane(tid >> 6), lane = tid & 63, wr = wid >> 2, wc = wid & 3, fr = lane & 15, fq = lane >> 4;
    const int K = g.K, nt = K / BK;
    unsigned voffA[2], voffB[2];
#pragma unroll
    for (int i = 0; i < 2; ++i) { int R, C; stage_rc(tid * 16 + i * 8192, R, C); const int Rb = Epi::PERM ? ((R & ~31) + perm32(R & 31)) : R;
        voffA[i] = (unsigned)(R * K + C) * 2u; voffB[i] = (unsigned)(Rb * K + C) * 2u; }
    const size_t kstep = (size_t)(BK * 2);
    const size_t hstep = (size_t)HALF * K * 2;
    const size_t tstep = 2 * hstep;
    const unsigned ldsw = (unsigned)wid * 1024u;
    const int aoff = lds_byte(wr * 64 + fr, fq * 8), boff = lds_byte(wc * 32 + fr, fq * 8);
#define PG8_SA(b, h) (((b) * 2 + (h)) * HTB)
#define PG8_SB(b, h) ((4 + (b) * 2 + (h)) * HTB)
#define PG8_STAGE(bufoff, gbase, voff) do { _Pragma("unroll") for (int _i = 0; _i < 2; ++_i) \
        __builtin_amdgcn_global_load_lds((const unsigned*)((const char*)(gbase) + (voff)[_i]), (PG8_LAS unsigned*)(lds + (bufoff) + ldsw + _i * 8192), 16, 0, 0); } while (0)
#define PG8_LDA(dst, b, h) do { _Pragma("unroll") for (int m = 0; m < 4; ++m) _Pragma("unroll") for (int k = 0; k < 2; ++k) dst[m][k] = *(const PG8_LAS bf16x8*)(lds + PG8_SA(b, h) + aoff + m * 2048 + k * 1024); } while (0)
#define PG8_LDB(dst, b, h) do { _Pragma("unroll") for (int n = 0; n < 2; ++n) _Pragma("unroll") for (int k = 0; k < 2; ++k) dst[n][k] = *(const PG8_LAS bf16x8*)(lds + PG8_SB(b, h) + boff + n * 2048 + k * 1024); } while (0)
#define PG8_MMA(ai, bj, At, Bt) do { __builtin_amdgcn_s_setprio(1); _Pragma("unroll") for (int m = 0; m < 4; ++m) _Pragma("unroll") for (int n = 0; n < 2; ++n) _Pragma("unroll") for (int k = 0; k < 2; ++k) \
        acc[ai][bj][m][n] = __builtin_amdgcn_mfma_f32_16x16x32_bf16(Bt[n][k], At[m][k], acc[ai][bj][m][n], 0, 0, 0); __builtin_amdgcn_s_setprio(0); } while (0)
#define PG8_WAIT_V(n) asm volatile("s_waitcnt vmcnt(" #n ")" ::: "memory")
#define PG8_WAIT_L(n) asm volatile("s_waitcnt lgkmcnt(" #n ")" ::: "memory")
#define PG8_BAR __builtin_amdgcn_s_barrier()
#define PG8_SCHED __builtin_amdgcn_sched_barrier(0)
    Unit cur, nxt; int ui = 0;
    if (!S.next(0, cur)) return;
    f32x4 acc[2][2][4][2];
#pragma unroll
    for (int a = 0; a < 2; ++a)
#pragma unroll
        for (int b = 0; b < 2; ++b)
#pragma unroll
            for (int m = 0; m < 4; ++m)
#pragma unroll
                for (int n = 0; n < 2; ++n) acc[a][b][m][n] = (f32x4){0.f, 0.f, 0.f, 0.f};
    bf16x8 At[4][2], B0[2][2], B1[2][2];
    const char* cA = (const char*)g.A + (size_t)cur.pm * tstep; const char* cB = (const char*)g.Bt + (size_t)cur.pn * tstep;
    S.a_ready(cur);
    if constexpr (SP2) {
        PG8_STAGE(PG8_SB(0, 0), cB, voffB); PG8_STAGE(PG8_SB(0, 1), cB + hstep, voffB); PG8_STAGE(PG8_SA(0, 0), cA, voffA); PG8_STAGE(PG8_SA(0, 1), cA + hstep, voffA);
        if (wr == 1) PG8_BAR;
        PG8_WAIT_V(2); PG8_BAR;
        PG8_STAGE(PG8_SB(1, 0), cB + kstep, voffB); PG8_STAGE(PG8_SA(1, 0), cA + kstep, voffA); PG8_STAGE(PG8_SB(1, 1), cB + hstep + kstep, voffB);
        PG8_WAIT_V(6); PG8_BAR;
    } else {
        PG8_STAGE(PG8_SB(0, 0), cB, voffB); PG8_STAGE(PG8_SA(0, 0), cA, voffA); PG8_STAGE(PG8_SB(0, 1), cB + hstep, voffB); PG8_STAGE(PG8_SA(0, 1), cA + hstep, voffA);
        if (wr == 1) PG8_BAR;
        PG8_WAIT_V(4); PG8_BAR;
        PG8_STAGE(PG8_SB(1, 0), cB + kstep, voffB); PG8_STAGE(PG8_SA(1, 0), cA + kstep, voffA); PG8_STAGE(PG8_SB(1, 1), cB + hstep + kstep, voffB);
        PG8_WAIT_V(6); PG8_BAR;
    }
    for (;;) {
        const bool has_next = S.next(ui + 1, nxt);
        const char* nA = has_next ? (const char*)g.A + (size_t)nxt.pm * tstep : cA; const char* nB = has_next ? (const char*)g.Bt + (size_t)nxt.pn * tstep : cB;
        for (int t = 0; t < nt; t += 2) {
            const bool last = (t == nt - 2);
            const char* a1 = cA + (size_t)(t + 1) * kstep;
            const char* a2 = last ? nA : cA + (size_t)(t + 2) * kstep; const char* b2 = last ? nB : cB + (size_t)(t + 2) * kstep;
            const char* a3 = a2 + kstep; const char* b3 = b2 + kstep;
            if (last && has_next) S.a_ready(nxt);
            if constexpr (SP2) {
            PG8_LDB(B0, 0, 0); PG8_LDB(B1, 0, 1); PG8_SCHED; PG8_LDA(At, 0, 0); PG8_STAGE(PG8_SA(1, 1), a1 + hstep, voffA);
            PG8_WAIT_V(8); PG8_WAIT_L(0); PG8_BAR; PG8_MMA(0, 0, At, B0); PG8_MMA(0, 1, At, B1); PG8_BAR; PG8_SCHED;
            PG8_LDA(At, 0, 1); PG8_STAGE(PG8_SB(0, 0), b2, voffB); PG8_STAGE(PG8_SB(0, 1), b2 + hstep, voffB); PG8_STAGE(PG8_SA(0, 0), a2, voffA);
            PG8_WAIT_V(8); PG8_WAIT_L(0); PG8_BAR; PG8_MMA(1, 0, At, B0); PG8_MMA(1, 1, At, B1); PG8_BAR; PG8_SCHED;
            PG8_LDB(B0, 1, 0); PG8_LDB(B1, 1, 1); PG8_SCHED; PG8_LDA(At, 1, 0); PG8_STAGE(PG8_SA(0, 1), a2 + hstep, voffA);
            PG8_WAIT_V(8); PG8_WAIT_L(0); PG8_BAR; PG8_MMA(0, 0, At, B0); PG8_MMA(0, 1, At, B1); PG8_BAR; PG8_SCHED;
            PG8_LDA(At, 1, 1); PG8_STAGE(PG8_SB(1, 0), b3, voffB); PG8_STAGE(PG8_SB(1, 1), b3 + hstep, voffB); PG8_STAGE(PG8_SA(1, 0), a3, voffA);
            PG8_WAIT_V(8); PG8_WAIT_L(0); PG8_BAR; PG8_MMA(1, 0, At, B0); PG8_MMA(1, 1, At, B1); PG8_BAR; PG8_SCHED;
            } else {
            PG8_LDB(B0, 0, 0); PG8_SCHED; PG8_LDA(At, 0, 0); PG8_STAGE(PG8_SA(1, 1), a1 + hstep, voffA);
            PG8_WAIT_L(8); PG8_BAR; PG8_WAIT_L(0); PG8_MMA(0, 0, At, B0); PG8_BAR; PG8_SCHED;
            PG8_LDB(B1, 0, 1); PG8_STAGE(PG8_SB(0, 0), b2, voffB);
            PG8_BAR; PG8_WAIT_L(0); PG8_MMA(0, 1, At, B1); PG8_BAR;
            PG8_LDA(At, 0, 1); PG8_STAGE(PG8_SA(0, 0), a2, voffA);
            PG8_BAR; PG8_WAIT_L(0); PG8_MMA(1, 0, At, B0); PG8_BAR; PG8_SCHED;
            PG8_STAGE(PG8_SB(0, 1), b2 + hstep, voffB);
            PG8_WAIT_V(6); PG8_BAR; PG8_MMA(1, 1, At, B1); PG8_BAR;
            PG8_LDB(B0, 1, 0); PG8_SCHED; PG8_LDA(At, 1, 0); PG8_STAGE(PG8_SA(0, 1), a2 + hstep, voffA);
            PG8_WAIT_L(8); PG8_BAR; PG8_WAIT_L(0); PG8_MMA(0, 0, At, B0); PG8_BAR; PG8_SCHED;
            PG8_LDB(B1, 1, 1); PG8_STAGE(PG8_SB(1, 0), b3, voffB);
            PG8_BAR; PG8_WAIT_L(0); PG8_MMA(0, 1, At, B1); PG8_BAR;
            PG8_LDA(At, 1, 1); PG8_STAGE(PG8_SA(1, 0), a3, voffA);
            PG8_BAR; PG8_WAIT_L(0); PG8_MMA(1, 0, At, B0); PG8_BAR; PG8_SCHED;
            PG8_STAGE(PG8_SB(1, 1), b3 + hstep, voffB);
            PG8_WAIT_V(6); PG8_BAR; PG8_MMA(1, 1, At, B1); PG8_BAR;
            }
        }
        if constexpr (ALIGN_EPI) { if (wr == 0) PG8_BAR; }
        if constexpr (!Epi::AFTER_DRAIN) { E(acc, cur, wr, wc, fr, fq); S.done(cur); }
        if (!has_next) break;
#pragma unroll
        for (int a = 0; a < 2; ++a)
#pragma unroll
            for (int b = 0; b < 2; ++b)
#pragma unroll
                for (int m = 0; m < 4; ++m)
#pragma unroll
                    for (int n = 0; n < 2; ++n) acc[a][b][m][n] = (f32x4){0.f, 0.f, 0.f, 0.f};
        cur = nxt; cA = nA; cB = nB; ++ui;
        if constexpr (ALIGN_EPI) { if (wr == 1) PG8_BAR; }
    }
    PG8_WAIT_V(0);
    if constexpr (!ALIGN_EPI) { if (wr == 0) PG8_BAR; }
    PG8_BAR;
    if constexpr (Epi::AFTER_DRAIN) { E.fused(acc, cur, wr, wc, fr, fq, lds, wid, lane); S.done(cur); }
#undef PG8_SA
#undef PG8_SB
#undef PG8_STAGE
#undef PG8_LDA
#undef PG8_LDB
#undef PG8_MMA
#undef PG8_WAIT_V
#undef PG8_WAIT_L
#undef PG8_BAR
#undef PG8_SCHED
}
}
#define XB_TMO      128
#define XB_XCNT(j)  (256  + 64 * (j))
#define XB_XSUB(j)  (1280 + 64 * (j))
#define XB_XGEN(j)  (2304 + 64 * (j))
#define XB_TOP      3328
#define XB_TOPGEN   3392
#define XCD_BAR_WORDS 3456
#define XB_SPIN_CAP (1u << 18)
#define LAS __attribute__((address_space(3)))

__device__ __forceinline__ unsigned xb_ld(unsigned* p)              { return __hip_atomic_load(p, __ATOMIC_RELAXED, __HIP_MEMORY_SCOPE_AGENT); }
__device__ __forceinline__ unsigned xb_add(unsigned* p, unsigned v) { return __hip_atomic_fetch_add(p, v, __ATOMIC_RELAXED, __HIP_MEMORY_SCOPE_AGENT); }
__device__ __forceinline__ unsigned xb_xcc_id() { return (unsigned)__builtin_amdgcn_s_getreg((3 << 11) | 20) & 0xFu; }
#define XB_SPIN(cond, bar) do { unsigned _sp = 0; while (cond) { __builtin_amdgcn_s_sleep(1); \
    if ((++_sp & 255u) == 0u) { if (xb_ld(&(bar)[XB_TMO])) break; if (_sp > XB_SPIN_CAP) { atomicAdd(&(bar)[XB_TMO], 1u); break; } } } } while (0)

struct XcdBarrier {
    unsigned* bar; unsigned x;
    volatile LAS unsigned* st;
};

__device__ __forceinline__ XcdBarrier xcd_barrier_post(unsigned* bar, volatile LAS unsigned* st) {
    XcdBarrier b; b.bar = bar; b.x = xb_xcc_id(); b.st = st;
    if (threadIdx.x == 0) (void)xb_add(&bar[XB_XCNT(b.x)], 1u);
    return b;
}
__device__ __forceinline__ void xcd_barrier_complete(unsigned* bar, unsigned x, unsigned& nloc, unsigned& nx) {
    const unsigned G = gridDim.x * gridDim.y * gridDim.z;
    unsigned sum, cnt, mine, sp = 0u;
    for (;;) {
        sum = 0u; cnt = 0u; mine = 0u;
#pragma unroll
        for (unsigned j = 0; j < 16; ++j) { const unsigned c = xb_ld(&bar[XB_XCNT(j)]); sum += c; cnt += (c > 0u) ? 1u : 0u; mine = (j == x) ? c : mine; }
        if (sum == G) break;
        __builtin_amdgcn_s_sleep(1);
        if ((++sp & 255u) == 0u) { if (xb_ld(&bar[XB_TMO])) break; if (sp > XB_SPIN_CAP) { atomicAdd(&bar[XB_TMO], 1u); break; } }
    }
    nloc = mine > 0u ? mine : 1u; nx = cnt > 0u ? cnt : 1u;
}

__device__ __forceinline__ void xcd_barrier(const XcdBarrier& b) {
    asm volatile("s_waitcnt vmcnt(0)" ::: "memory");
    __syncthreads();
    if (threadIdx.x == 0) {
        unsigned* bar = b.bar;
        __builtin_amdgcn_s_waitcnt(0);
        unsigned nloc = b.st[0], nx = b.st[1];
        if (nloc == 0u) { xcd_barrier_complete(bar, b.x, nloc, nx); b.st[0] = nloc; b.st[1] = nx; }
        const unsigned old = xb_add(&bar[XB_XSUB(b.x)], 1u);
        const unsigned gen = old / nloc;
        if (old + 1u == (gen + 1u) * nloc) {
            __builtin_amdgcn_fence(__ATOMIC_RELEASE, "agent");
            asm volatile("s_waitcnt vmcnt(0)" ::: "memory");
            const unsigned og = xb_add(&bar[XB_TOP], 1u);
            const unsigned tg = og / nx;
            if (og + 1u == (tg + 1u) * nx) xb_add(&bar[XB_TOPGEN], 1u);
            else XB_SPIN(xb_ld(&bar[XB_TOPGEN]) == tg, bar);
            __builtin_amdgcn_fence(__ATOMIC_ACQUIRE, "agent");
            xb_add(&bar[XB_XGEN(b.x)], 1u);
            asm volatile("s_waitcnt vmcnt(0)" ::: "memory");
        } else {
            XB_SPIN(xb_ld(&bar[XB_XGEN(b.x)]) == gen, bar);
            __builtin_amdgcn_fence(__ATOMIC_ACQUIRE, "agent");
            asm volatile("s_waitcnt vmcnt(0)" ::: "memory");
        }
    }
    __syncthreads();
}


typedef float f32x4 __attribute__((ext_vector_type(4)));
__device__ __forceinline__ float wave_sum(float v) {
#pragma unroll
    for (int o = 1; o < 64; o <<= 1) v += __shfl_xor(v, o);
    return v;
}
__device__ __forceinline__ float wave_max(float v) {
#pragma unroll
    for (int o = 1; o < 64; o <<= 1) v = fmaxf(v, __shfl_xor(v, o));
    return v;
}
__device__ __forceinline__ float sigmoidf_(float x) { return 1.0f / (1.0f + expf(-x)); }
__device__ __forceinline__ float siluf_(float x) { return x / (1.0f + expf(-x)); }
__device__ __forceinline__ int seq_of_row(int r) { return r < MP ? r / TP : NP + (r - MP) / TS; }
__device__ __forceinline__ unsigned f2bf(float f) { unsigned u = __builtin_bit_cast(unsigned, f); return (u + 0x7fffu + ((u >> 16) & 1u)) >> 16; }
__device__ __forceinline__ unsigned pk2(float lo, float hi) { return f2bf(lo) | (f2bf(hi) << 16); }
__host__ __device__ __forceinline__ int phys_row(int n) { return (n & ~255) + ((n >> 5) & 1) * 128 + ((n >> 6) & 3) * 32 + (n & 31); }

struct EpiU {
    static constexpr bool PERM = true, AFTER_DRAIN = false; float* U;
    __device__ __forceinline__ void operator()(const pg8::f32x4 (&acc)[2][2][4][2], const pg8::Unit& u, int wr, int wc, int fr, int fq) const {
        const int row0 = u.pm * 256 + wr * 64 + fr, lc0 = u.pn * 256 + wc * 64 + fq * 8;
#pragma unroll
        for (int ai = 0; ai < 2; ++ai)
#pragma unroll
            for (int m = 0; m < 4; ++m) { float* rowp = U + (size_t)(row0 + ai * 128 + m * 16) * NIN + lc0;
#pragma unroll
                for (int bj = 0; bj < 2; ++bj) { *(pg8::f32x4*)(rowp + bj * 32) = acc[ai][bj][m][0]; *(pg8::f32x4*)(rowp + bj * 32 + 4) = acc[ai][bj][m][1]; } }
    }
};
struct EpiGA {
    static constexpr bool PERM = true, AFTER_DRAIN = false; float* MGF; const float* U;
    __device__ __forceinline__ void operator()(const pg8::f32x4 (&acc)[2][2][4][2], const pg8::Unit& u, int wr, int wc, int fr, int fq) const {
        const int row0 = u.pm * 256 + wr * 64 + fr, lc0 = u.pn * 256 + wc * 64 + fq * 8;
#pragma unroll
        for (int ai = 0; ai < 2; ++ai)
#pragma unroll
            for (int m = 0; m < 4; ++m) { const int row = row0 + ai * 128 + m * 16;
#pragma unroll
                for (int bj = 0; bj < 2; ++bj)
#pragma unroll
                    for (int n = 0; n < 2; ++n) { const int c = lc0 + bj * 32 + n * 4; const pg8::f32x4 g = *(const pg8::f32x4*)(U + (size_t)row * NIN + C_GA + c); pg8::f32x4 o;
#pragma unroll
                        for (int j = 0; j < 4; ++j) o[j] = sigmoidf_(g[j]) * acc[ai][bj][m][n][j];
                        *(pg8::f32x4*)(MGF + (size_t)row * D + c) = o; } }
    }
};
struct EpiGB {
    static constexpr bool PERM = true, AFTER_DRAIN = false; const float* MGF; const float* U; bf16* MG;
    __device__ __forceinline__ void operator()(const pg8::f32x4 (&acc)[2][2][4][2], const pg8::Unit& u, int wr, int wc, int fr, int fq) const {
        const int row0 = u.pm * 256 + wr * 64 + fr, lc0 = u.pn * 256 + wc * 64 + fq * 8;
#pragma unroll
        for (int ai = 0; ai < 2; ++ai)
#pragma unroll
            for (int m = 0; m < 4; ++m) { const int row = row0 + ai * 128 + m * 16;
#pragma unroll
                for (int bj = 0; bj < 2; ++bj) { const int c = lc0 + bj * 32; float o[8];
#pragma unroll
                    for (int n = 0; n < 2; ++n) { const pg8::f32x4 g = *(const pg8::f32x4*)(U + (size_t)row * NIN + C_GB + c + n * 4); const pg8::f32x4 p = *(const pg8::f32x4*)(MGF + (size_t)row * D + c + n * 4);
#pragma unroll
                        for (int j = 0; j < 4; ++j) o[n * 4 + j] = p[j] + sigmoidf_(g[j]) * acc[ai][bj][m][n][j]; }
                    v4u w; w.x = pk2(o[0], o[1]); w.y = pk2(o[2], o[3]); w.z = pk2(o[4], o[5]); w.w = pk2(o[6], o[7]);
                    *(v4u*)(MG + (size_t)row * D + c) = w; } }
    }
};
struct EpiY {
    static constexpr bool PERM = true, AFTER_DRAIN = false; float* out; const float* xp; const float* xs; const float* ada;
    __device__ __forceinline__ void operator()(const pg8::f32x4 (&acc)[2][2][4][2], const pg8::Unit& u, int wr, int wc, int fr, int fq) const {
        const int row0 = u.pm * 256 + wr * 64 + fr, lc0 = u.pn * 256 + wc * 64 + fq * 8;
#pragma unroll
        for (int ai = 0; ai < 2; ++ai)
#pragma unroll
            for (int m = 0; m < 4; ++m) { const int row = row0 + ai * 128 + m * 16; const int sq = seq_of_row(row);
                const float* xr = row < MP ? xp + (size_t)row * D : xs + (size_t)(row - MP) * D;
                float* orow = out + (row < MP ? O_YP + (size_t)row * D : O_YS + (size_t)(row - MP) * D);
                const float* gr = ada + (size_t)sq * 3072 + 2048;
#pragma unroll
                for (int bj = 0; bj < 2; ++bj)
#pragma unroll
                    for (int n = 0; n < 2; ++n) { const int c = lc0 + bj * 32 + n * 4; const pg8::f32x4 g = *(const pg8::f32x4*)(gr + c), x = *(const pg8::f32x4*)(xr + c);
                        *(pg8::f32x4*)(orow + c) = x + g * acc[ai][bj][m][n]; } }
    }
};

__device__ __forceinline__ void p0_transpose_item(const float* W, int K, int N, bf16* WT, LAS float* scr, int item, int lane) {
    const int nblk = N / 32, kb = item / nblk, nb = item % nblk, k0 = 64 * kb, n0 = 32 * nb;
#pragma unroll 8
    for (int i = 0; i < 32; ++i) { const int kk = 2 * i + (lane >> 5); scr[kk * 33 + (lane & 31)] = W[(size_t)(k0 + kk) * N + n0 + (lane & 31)]; }
    asm volatile("s_waitcnt lgkmcnt(0)" ::: "memory");
    const int c = lane & 7;
    const int pr0 = phys_row(n0);
#pragma unroll
    for (int j = 0; j < 4; ++j) { const int n = (lane >> 3) + 8 * j; const LAS float* s = scr + (8 * c) * 33 + n;
        v4u o; o.x = pk2(s[0 * 33], s[1 * 33]); o.y = pk2(s[2 * 33], s[3 * 33]); o.z = pk2(s[4 * 33], s[5 * 33]); o.w = pk2(s[6 * 33], s[7 * 33]);
        *(v4u*)(WT + (size_t)(pr0 + n) * K + k0 + 8 * c) = o; }
    asm volatile("s_waitcnt lgkmcnt(0)" ::: "memory");
}

#ifndef MK_ONE_LAUNCH
#define MK_ONE_LAUNCH 1
#endif
constexpr int NPHASE = 8;

struct Args { const float* in[19]; float* out; unsigned char* ws; int ph_lo, ph_hi; };

__global__ void __launch_bounds__(NTHR, 2) fwd(Args a) {
    extern __shared__ __attribute__((aligned(16))) unsigned char lds_raw[];
    float* lds = (float*)lds_raw;
    LAS unsigned char* ldsb = (LAS unsigned char*)lds_raw;
    volatile LAS unsigned* MISC = (volatile LAS unsigned*)(ldsb + MISC_OFF);
    const int tid = threadIdx.x, lane = tid & 63, wave = __builtin_amdgcn_readfirstlane(tid >> 6);
    const int gw = blockIdx.x * NWAVES + wave, NGW = gridDim.x * NWAVES;
    const float* x_p = a.in[0]; const float* x_s = a.in[1];
    const float* cache[3] = {a.in[2], a.in[3], a.in[4]};
    const float* state_in = a.in[5]; const float* c_p = a.in[6]; const float* c_s = a.in[7];
    const float* norm_gain = a.in[8]; const float* w_ada = a.in[9]; const float* b_ada = a.in[10]; const float* w_in = a.in[11];
    const float* q_gain = a.in[12]; const float* k_gain = a.in[13]; const float* lb_logits = a.in[14]; const float* o_gain = a.in[15];
    const float* w_ba = a.in[16]; const float* w_bb = a.in[17]; const float* w_out = a.in[18];
    float* out = a.out;
    unsigned* ctl = (unsigned*)(a.ws + WS_CTL);
    float* ADA = (float*)(a.ws + WS_ADA); float* LB = (float*)(a.ws + WS_LB);
    bf16* W1T = (bf16*)(a.ws + WS_W1T); bf16* WAT = (bf16*)(a.ws + WS_WAT); bf16* WBT = (bf16*)(a.ws + WS_WBT); bf16* WOT = (bf16*)(a.ws + WS_WOT);
    bf16* H = (bf16*)(a.ws + WS_H); float* U = (float*)(a.ws + WS_U);
    bf16* OA = (bf16*)(a.ws + WS_OA); bf16* OB = (bf16*)(a.ws + WS_OB); float* OBR = (float*)(a.ws + WS_OBR);
    float* MGF = (float*)(a.ws + WS_MGF); bf16* MG = (bf16*)(a.ws + WS_MG);
    const int lo = a.ph_lo, hi = a.ph_hi;
#define IN(k) (lo <= (k) && (k) < hi)
#define BOTH(k) (IN(k) && IN((k) + 1))

    for (int u = tid; u < (LDS_BYTES - RING_BYTES) / 4; u += NTHR) ((LAS unsigned*)(ldsb + RING_BYTES))[u] = 0u;
    __syncthreads();
    XcdBarrier bar; bar.bar = ctl + CW_BAR; bar.x = 0; bar.st = nullptr;
    if (MK_ONE_LAUNCH) bar = xcd_barrier_post(ctl + CW_BAR, MISC + 8);
#define GRID_BAR() do { if (MK_ONE_LAUNCH) xcd_barrier(bar); } while (0)

    if (IN(0)) {
        for (int it = blockIdx.x; it < NSEQ * 6; it += gridDim.x) {
            const int sq = it / 6, ch = it % 6;
            const float* c = sq < NP ? c_p + (size_t)sq * D : c_s + (size_t)(sq - NP) * D;
            __syncthreads();
            for (int k = tid; k < D; k += NTHR) lds[k] = siluf_(c[k]);
            __syncthreads();
            const int col = ch * 512 + tid;
            float acc = b_ada[col];
            for (int k = 0; k < D; ++k) acc = fmaf(lds[k], w_ada[(size_t)k * 3072 + col], acc);
            ADA[(size_t)sq * 3072 + col] = acc;
        }
        if (blockIdx.x == 0) {
            const float l0 = lb_logits[tid], l1 = lb_logits[512 + tid];
            const float mx = fmaxf(l0, l1); const float e0 = expf(l0 - mx), e1 = expf(l1 - mx);
            LB[tid] = e0 / (e0 + e1);
        }
        __syncthreads();
        LAS float* scr = (LAS float*)(ldsb + wave * 16384);
        constexpr int I_1 = (D / 64) * (NIN / 32), I_A = (512 / 64) * (D / 32), I_O = (D / 64) * (D / 32);
        for (int it = gw; it < I_1 + 2 * I_A + I_O; it += NGW) {
            int r = it;
            if (r < I_1) { p0_transpose_item(w_in, D, NIN, W1T, scr, r, lane); continue; } r -= I_1;
            if (r < I_A) { p0_transpose_item(w_ba, 512, D, WAT, scr, r, lane); continue; } r -= I_A;
            if (r < I_A) { p0_transpose_item(w_bb, 512, D, WBT, scr, r, lane); continue; } r -= I_A;
            p0_transpose_item(w_out, D, D, WOT, scr, r, lane);
        }
        if (BOTH(0)) GRID_BAR();
    }
    if (IN(1)) {
        for (int r = gw; r < M; r += NGW) {
            const float* xr = r < MP ? x_p + (size_t)r * D : x_s + (size_t)(r - MP) * D;
            const int sq = seq_of_row(r);
            float4 v[4]; float ss = 0.f;
#pragma unroll
            for (int j = 0; j < 4; ++j) { v[j] = *(const float4*)(xr + 256 * j + 4 * lane); ss += v[j].x * v[j].x + v[j].y * v[j].y + v[j].z * v[j].z + v[j].w * v[j].w; }
            const float rstd = 1.0f / sqrtf(wave_sum(ss) * (1.0f / D) + EPS);
#pragma unroll
            for (int j = 0; j < 4; ++j) {
                const int c = 256 * j + 4 * lane;
                const float4 g = *(const float4*)(norm_gain + c), sh = *(const float4*)(ADA + (size_t)sq * 3072 + c), sc = *(const float4*)(ADA + (size_t)sq * 3072 + 1024 + c);
                float4 o; o.x = v[j].x * rstd * g.x * (1.f + sc.x) + sh.x; o.y = v[j].y * rstd * g.y * (1.f + sc.y) + sh.y;
                o.z = v[j].z * rstd * g.z * (1.f + sc.z) + sh.z; o.w = v[j].w * rstd * g.w * (1.f + sc.w) + sh.w;
                v2u w; w.x = pk2(o.x, o.y); w.y = pk2(o.z, o.w);
                *(v2u*)(H + (size_t)r * D + c) = w;
            }
        }
        if (BOTH(1)) GRID_BAR();
    }
    if (IN(2)) {
        pg8::Gemm g{H, W1T, M, NIN, D}; pg8::StaticOrder S; S.init(M, NIN, gridDim.x, (int)blockIdx.x);
        EpiU E{U};
        pg8::gemm_phase<EpiU, pg8::StaticOrder, true, true>(ldsb, g, S, E);
        if (BOTH(2)) GRID_BAR();
    }
    if (IN(3)) {
        for (int r = gw; r < M; r += NGW) {
            float* ur = U + (size_t)r * NIN;
            const bool prompt = r < MP; const int n = prompt ? r / TP : (r - MP) / TS, t = prompt ? r % TP : (r - MP) % TS;
            for (int hd = 0; hd < 48; ++hd) {
                const float v = ur[hd * 64 + lane];
                const float ss = wave_sum(v * v);
                const float gn = hd < 24 ? q_gain[lane] : k_gain[lane];
                ur[hd * 64 + lane] = v * (1.0f / sqrtf(ss * (1.0f / 64.f) + EPS)) * gn;
            }
#pragma unroll
            for (int g = 0; g < 3; ++g) {
                const int W = g == 0 ? 128 : (g == 1 ? 512 : 2048);
                float* dst;
                if (prompt) { if (t < TP - W) continue; dst = out + (g == 0 ? O_KVP0 : (g == 1 ? O_KVP1 : O_KVP2)) + ((size_t)n * W + (t - (TP - W))) * 1024; }
                else dst = out + (g == 0 ? O_KVS0 : (g == 1 ? O_KVS1 : O_KVS2)) + ((size_t)n * TS + t) * 1024;
                for (int j = 0; j < 8; ++j) { dst[j * 64 + lane] = ur[C_KA + g * 512 + j * 64 + lane]; dst[512 + j * 64 + lane] = ur[C_VA + g * 512 + j * 64 + lane]; }
            }
            for (int c = lane; c < 512; c += 64) {
                ur[C_QB + c] = siluf_(ur[C_QB + c]);
                const float lb = LB[c];
                ur[C_FB + c] = lb + (1.f - lb) * sigmoidf_(ur[C_FB + c]);
            }
        }
        if (BOTH(3)) GRID_BAR();
    }
    if (IN(4)) {
        {
            const int c = lane >> 2, qt = lane & 3;
            for (int it = wave * gridDim.x + blockIdx.x; it < NSEQ * 4 * 8; it += NGW) {
                const int sq = it / 32, h = (it / 8) % 4, cg = it % 8;
                const bool prompt = sq < NP;
                const int T = prompt ? TP : TS; const int row0 = prompt ? sq * TP : MP + (sq - NP) * TS;
                const int icol = cg * 16 + c;
                float S[32];
                if (prompt) {
#pragma unroll
                    for (int ff = 0; ff < 32; ++ff) S[ff] = 0.f;
                } else {
                    const float* s0 = state_in + (((size_t)(sq - NP) * 4 + h) * 128) * 128;
#pragma unroll
                    for (int ff = 0; ff < 32; ++ff) S[ff] = s0[(size_t)(qt * 32 + ff) * 128 + icol];
                }
                for (int t = 0; t < T; ++t) {
                    const float* ur = U + (size_t)(row0 + t) * NIN;
                    const float vi = ur[C_IB + h * 128 + icol];
                    float part = 0.f;
#pragma unroll
                    for (int f4 = 0; f4 < 8; ++f4) {
                        const float4 q = *(const float4*)(ur + C_QB + h * 128 + qt * 32 + f4 * 4);
                        const float4 f = *(const float4*)(ur + C_FB + h * 128 + qt * 32 + f4 * 4);
                        S[f4 * 4 + 0] = f.x * S[f4 * 4 + 0] + (1.f - f.x) * vi; part = fmaf(q.x, S[f4 * 4 + 0], part);
                        S[f4 * 4 + 1] = f.y * S[f4 * 4 + 1] + (1.f - f.y) * vi; part = fmaf(q.y, S[f4 * 4 + 1], part);
                        S[f4 * 4 + 2] = f.z * S[f4 * 4 + 2] + (1.f - f.z) * vi; part = fmaf(q.z, S[f4 * 4 + 2], part);
                        S[f4 * 4 + 3] = f.w * S[f4 * 4 + 3] + (1.f - f.w) * vi; part = fmaf(q.w, S[f4 * 4 + 3], part);
                    }
                    part += __shfl_xor(part, 1); part += __shfl_xor(part, 2);
                    if (qt == 0) OBR[(size_t)(row0 + t) * 512 + h * 128 + icol] = part;
                }
                float* so = prompt ? out + O_HP + (((size_t)sq * 4 + h) * 128) * 128 : out + O_HS + (((size_t)(sq - NP) * 4 + h) * 128) * 128;
#pragma unroll
                for (int ff = 0; ff < 32; ++ff) so[(size_t)(qt * 32 + ff) * 128 + icol] = S[ff];
            }
        }
        {
            float* qs = lds + wave * 1024;
            float* ps = qs + 192;
            for (int it = gw; it < M * 8; it += NGW) {
                const int r = it >> 3, j = it & 7;
                const bool prompt = r < MP; const int n = prompt ? r / TP : (r - MP) / TS, t = prompt ? r % TP : (r - MP) % TS;
                const float* ur = U + (size_t)r * NIN;
#pragma unroll
                for (int g = 0; g < 3; ++g) qs[g * 64 + lane] = ur[C_QA + g * 512 + j * 64 + lane];
                __builtin_amdgcn_s_waitcnt(0);
                __builtin_amdgcn_wave_barrier();
                float sc[3][3]; float mx = -INFINITY;
#pragma unroll
                for (int g = 0; g < 3; ++g) {
                    const int dil = g == 0 ? 1 : (g == 1 ? 4 : 16), wb = g == 0 ? 128 : (g == 1 ? 512 : 2048);
                    const float slope = exp2f(-8.0f * (float)(g * 8 + j + 1) / 24.0f);
#pragma unroll
                    for (int ch = 0; ch < 3; ++ch) {
                        const int s = ch * 64 + lane;
                        float v = -INFINITY;
                        if (s <= 128) {
                            const float* kp = nullptr;
                            if (prompt) { const int tk = t - s * dil; if (tk >= 0) kp = U + (size_t)(n * TP + tk) * NIN + C_KA + g * 512 + j * 64; }
                            else { const int idx = wb + t - s * dil;
                                if (idx >= wb) kp = U + (size_t)(MP + n * TS + idx - wb) * NIN + C_KA + g * 512 + j * 64;
                                else if (idx >= 0) kp = cache[g] + (((size_t)n * wb + idx) * 2 + 0) * 512 + j * 64; }
                            if (kp) {
                                float d = 0.f;
#pragma unroll
                                for (int q4 = 0; q4 < 16; ++q4) { const float4 kk = *(const float4*)(kp + q4 * 4); const float4 qq = *(const float4*)(qs + g * 64 + q4 * 4);
                                    d = fmaf(qq.x, kk.x, d); d = fmaf(qq.y, kk.y, d); d = fmaf(qq.z, kk.z, d); d = fmaf(qq.w, kk.w, d); }
                                v = d * 0.125f - slope * (float)(s * dil);
                            }
                        }
                        sc[g][ch] = v; mx = fmaxf(mx, v);
                    }
                }
                mx = wave_max(mx);
                float l = 0.f;
#pragma unroll
                for (int g = 0; g < 3; ++g)
#pragma unroll
                    for (int ch = 0; ch < 3; ++ch) { const float p = expf(sc[g][ch] - mx); l += p; const int s = ch * 64 + lane; if (s < 192) ps[g * 192 + s] = p; }
                l = wave_sum(l);
                __builtin_amdgcn_s_waitcnt(0);
                __builtin_amdgcn_wave_barrier();
                float o = 0.f;
#pragma unroll
                for (int g = 0; g < 3; ++g) {
                    const int dil = g == 0 ? 1 : (g == 1 ? 4 : 16), wb = g == 0 ? 128 : (g == 1 ? 512 : 2048);
                    for (int s = 0; s <= 128; ++s) {
                        const float* vp;
                        if (prompt) { const int tk = t - s * dil; if (tk < 0) break; vp = U + (size_t)(n * TP + tk) * NIN + C_VA + g * 512 + j * 64; }
                        else { const int idx = wb + t - s * dil; if (idx < 0) break;
                            vp = idx >= wb ? U + (size_t)(MP + n * TS + idx - wb) * NIN + C_VA + g * 512 + j * 64 : cache[g] + (((size_t)n * wb + idx) * 2 + 1) * 512 + j * 64; }
                        o = fmaf(ps[g * 192 + s], vp[lane], o);
                    }
                }
                OA[(size_t)r * 512 + j * 64 + lane] = (bf16)f2bf((o / l) * siluf_(ur[C_ZA + j * 64 + lane]));
                __builtin_amdgcn_wave_barrier();
            }
        }
        if (BOTH(4)) GRID_BAR();
    }
    if (IN(5)) {
        for (int it = gw; it < M * 4; it += NGW) {
            const int r = it >> 2, h = it & 3;
            const float* ob = OBR + (size_t)r * 512 + h * 128; const float* zb = U + (size_t)r * NIN + C_ZB + h * 128;
            const float v0 = ob[lane], v1 = ob[64 + lane];
            const float rstd = 1.0f / sqrtf(wave_sum(v0 * v0 + v1 * v1) * (1.0f / 128.f) + EPS);
            OB[(size_t)r * 512 + h * 128 + lane] = (bf16)f2bf(v0 * rstd * o_gain[lane] * siluf_(zb[lane]));
            OB[(size_t)r * 512 + h * 128 + 64 + lane] = (bf16)f2bf(v1 * rstd * o_gain[64 + lane] * siluf_(zb[64 + lane]));
        }
        if (BOTH(5)) GRID_BAR();
    }
    if (IN(6)) {
        { pg8::Gemm g{OA, WAT, M, D, 512}; pg8::StaticOrder S; S.init(M, D, gridDim.x, (int)blockIdx.x); EpiGA E{MGF, U};
          pg8::gemm_phase<EpiGA, pg8::StaticOrder, true, true>(ldsb, g, S, E); }
        { pg8::Gemm g{OB, WBT, M, D, 512}; pg8::StaticOrder S; S.init(M, D, gridDim.x, (int)blockIdx.x); EpiGB E{MGF, U, MG};
          pg8::gemm_phase<EpiGB, pg8::StaticOrder, true, true>(ldsb, g, S, E); }
        if (BOTH(6)) GRID_BAR();
    }
    if (IN(7)) {
        pg8::Gemm g{MG, WOT, M, D, D}; pg8::StaticOrder S; S.init(M, D, gridDim.x, (int)blockIdx.x); EpiY E{out, x_p, x_s, ADA};
        pg8::gemm_phase<EpiY, pg8::StaticOrder, true, true>(ldsb, g, S, E);
    }
#undef IN
#undef BOTH
}

extern "C" void kernel_launch(void* const* d_in, const int* in_sizes, int n_in, void* d_out, int out_size, void* d_ws, size_t ws_size, hipStream_t stream) {
    static int grid = 0;
    if (grid == 0) {
        if (n_in != 19 || (size_t)out_size != O_END || ws_size < WS_END) { fprintf(stderr, "kernel_launch: unexpected shapes (n_in %d out %d ws %zu)\n", n_in, out_size, ws_size); grid = -1; return; }
        int dev = 0, cus = 0, per_cu = 0;
        if (hipGetDevice(&dev) != hipSuccess || hipDeviceGetAttribute(&cus, hipDeviceAttributeMultiprocessorCount, dev) != hipSuccess) { grid = -1; return; }
        if (hipFuncSetAttribute((const void*)fwd, hipFuncAttributeMaxDynamicSharedMemorySize, LDS_BYTES) != hipSuccess) { fprintf(stderr, "kernel_launch: hipFuncSetAttribute failed\n"); grid = -1; return; }
        if (hipOccupancyMaxActiveBlocksPerMultiprocessor(&per_cu, (const void*)fwd, NTHR, LDS_BYTES) != hipSuccess || per_cu < 1) { fprintf(stderr, "kernel_launch: occupancy query says %d\n", per_cu); }
        (void)hipGetLastError();
        grid = cus;
    }
    if (grid < 0) return;
    hipMemsetAsync((char*)d_ws + WS_CTL, 0, CTL_ZERO_BYTES, stream);
    Args a{};
    for (int i = 0; i < 19; ++i) a.in[i] = (const float*)d_in[i];
    a.out = (float*)d_out; a.ws = (unsigned char*)d_ws;
#if MK_ONE_LAUNCH
    a.ph_lo = 0; a.ph_hi = NPHASE;
    hipLaunchKernelGGL(fwd, dim3(grid), dim3(NTHR), LDS_BYTES, stream, a);
#else
    for (int ph = 0; ph < NPHASE; ++ph) { a.ph_lo = ph; a.ph_hi = ph + 1; hipLaunchKernelGGL(fwd, dim3(grid), dim3(NTHR), LDS_BYTES, stream, a); }
#endif
}
```

```cpp
#include <hip/hip_runtime.h>
#include <cstdio>
#include <cstdint>

constexpr int D = 1024, NP = 4, TP = 4096, NS = 128, TS = 8;
constexpr int MP = NP * TP, MS = NS * TS, M = MP + MS;
constexpr int NIN = 9216;
constexpr int C_QA = 0, C_KA = 1536, C_VA = 3072, C_ZA = 4608, C_QB = 5120, C_FB = 5632, C_IB = 6144, C_ZB = 6656, C_GA = 7168, C_GB = 8192;
constexpr int NSEQ = NP + NS;
constexpr float EPS = 1e-6f;
constexpr int NTHR = 512, NWAVES = 8;

constexpr size_t O_YP = 0, O_YS = O_YP + (size_t)MP * D, O_KVP0 = O_YS + (size_t)MS * D, O_KVP1 = O_KVP0 + (size_t)NP * 128 * 1024,
                 O_KVP2 = O_KVP1 + (size_t)NP * 512 * 1024, O_HP = O_KVP2 + (size_t)NP * 2048 * 1024, O_KVS0 = O_HP + (size_t)NP * 4 * 128 * 128,
                 O_KVS1 = O_KVS0 + (size_t)MS * 1024, O_KVS2 = O_KVS1 + (size_t)MS * 1024, O_HS = O_KVS2 + (size_t)MS * 1024, O_END = O_HS + (size_t)NS * 4 * 128 * 128;

constexpr size_t MiB = 1u << 20;
constexpr size_t WS_CTL = 0, CTL_ZERO_BYTES = 1 * MiB;
constexpr size_t WS_ADA = 1 * MiB;
constexpr size_t WS_LB = 3 * MiB;
constexpr size_t WS_W1T = 4 * MiB;
constexpr size_t WS_WAT = 22 * MiB;
constexpr size_t WS_WBT = 23 * MiB;
constexpr size_t WS_WOT = 24 * MiB;
constexpr size_t WS_H = 26 * MiB;
constexpr size_t WS_QA = 64 * MiB;
constexpr size_t WS_KA = 116 * MiB;
constexpr size_t WS_VA = 168 * MiB;
constexpr size_t WS_ZA = 220 * MiB;
constexpr size_t WS_QB = 238 * MiB;
constexpr size_t WS_IB = 256 * MiB;
constexpr size_t WS_ZB = 274 * MiB;
constexpr size_t WS_LF = 292 * MiB;
constexpr size_t WS_GA = 328 * MiB;
constexpr size_t WS_GB = 364 * MiB;
constexpr size_t WS_OA = 400 * MiB;
constexpr size_t WS_OBR = 436 * MiB;
constexpr size_t WS_MGF = 472 * MiB;
constexpr size_t WS_MG = 542 * MiB;
constexpr size_t WS_OG = 578 * MiB;
constexpr size_t WS_LSE = 630 * MiB;
constexpr size_t WS_DS = 634 * MiB;
constexpr size_t WS_DEC = 698 * MiB;
constexpr size_t WS_SB = 700 * MiB;
constexpr size_t WS_END = 732 * MiB;
constexpr float QSCALE = 0.125f * 1.4426950408889634f;
constexpr float LOG2E = 1.4426950408889634f;
constexpr int CW_ADA = 1024;
constexpr int CW_BAR = 4096;

constexpr int RING_BYTES = 131072, MISC_OFF = RING_BYTES + 320, LDS_BYTES = 147456;

#define GAS __attribute__((address_space(1)))
#define LAS __attribute__((address_space(3)))
typedef unsigned short bf16;
typedef unsigned v4u __attribute__((ext_vector_type(4)));
typedef unsigned v2u __attribute__((ext_vector_type(2)));

namespace pg8 {
#define PG8_LAS __attribute__((address_space(3)))
typedef unsigned short bf16_t;
typedef short bf16x8 __attribute__((ext_vector_type(8)));
typedef float f32x4 __attribute__((ext_vector_type(4)));
typedef unsigned u32x4 __attribute__((ext_vector_type(4)));
constexpr int BM = 256, BK = 64, HALF = 128, HTB = HALF * BK * 2  , STAGE_BYTES = 8 * HTB, NXCD = 8, WGM = 4;

__host__ __device__ __forceinline__ int lds_byte(int r, int c) { const int st = (r >> 4) * 2 + (c >> 5), rr = r & 15, cc = c & 31, ob = rr * 64 + cc * 2; return st * 1024 + (ob ^ (((ob >> 9) & 1) << 5)); }
__host__ __device__ __forceinline__ void stage_rc(int b, int& R, int& C) { const int st = b / 1024, sb = b % 1024, swz = sb ^ (((sb >> 9) & 1) << 5); R = (st >> 1) * 16 + swz / 64; C = (st & 1) * 32 + (swz % 64) / 2; }
__host__ __device__ __forceinline__ int perm32(int rho) { const int n = rho >> 4, i = rho & 15; return 8 * (i >> 2) + 4 * n + (i & 3); }

struct Unit { int pm, pn; };
struct Gemm { const bf16_t* A; const bf16_t* Bt; int M, N, K; };

struct StaticOrder {
    int nM, nN, nwg, G, c;
    __host__ __device__ void init(int M, int N, int G_, int c_) { nM = M / BM; nN = N / BM; nwg = nM * nN; G = G_; c = c_; }
    __host__ __device__ bool next(int i, Unit& u) const {
        const long L = (long)i * G + c; if (L >= nwg) return false;
        int wgid = (int)L; { const int q = nwg / NXCD, r = nwg % NXCD, xcd = wgid % NXCD, off = wgid / NXCD; wgid = (xcd < r ? xcd * (q + 1) : r * (q + 1) + (xcd - r) * q) + off; }
        const int nig = WGM * nN, gid = wgid / nig, fm = gid * WGM, gsz = (nM - fm) < WGM ? (nM - fm) : WGM;
        u.pm = fm + ((wgid % nig) % gsz); u.pn = (wgid % nig) / gsz; return true;
    }
    __device__ __forceinline__ void a_ready(const Unit&) const {}
    __device__ __forceinline__ void done(const Unit&) const {}
};

__device__ __forceinline__ unsigned cvt_pk_bf16(float lo, float hi) { unsigned r; asm volatile("v_cvt_pk_bf16_f32 %0, %1, %2" : "=v"(r) : "v"(lo), "v"(hi)); return r; }
template <class E, class = void> struct pg8_has_midk { static constexpr bool value = false; };
template <class E> struct pg8_has_midk<E, decltype((void)E::MIDK)> { static constexpr bool value = E::MIDK; };
template <class Epi, class Sched, bool ALIGN_EPI = false, bool SP2 = false>
__device__ __forceinline__ void gemm_phase(PG8_LAS unsigned char* lds, const Gemm g, const Sched& S, const Epi& E) {
    const int tid = threadIdx.x, wid = __builtin_amdgcn_readfirstlane(tid >> 6), lane = tid & 63, wr = wid >> 2, wc = wid & 3, fr = lane & 15, fq = lane >> 4;
    const int K = g.K, nt = K / BK;
    unsigned voffA[2], voffB[2];
#pragma unroll
    for (int i = 0; i < 2; ++i) { int R, C; stage_rc(tid * 16 + i * 8192, R, C); const int Rb = Epi::PERM ? ((R & ~31) + perm32(R & 31)) : R;
        voffA[i] = (unsigned)(R * K + C) * 2u; voffB[i] = (unsigned)(Rb * K + C) * 2u; }
    const size_t kstep = (size_t)(BK * 2);
    const size_t hstep = (size_t)HALF * K * 2;
    const size_t tstep = 2 * hstep;
    const unsigned ldsw = (unsigned)wid * 1024u;
    const int aoff = lds_byte(wr * 64 + fr, fq * 8), boff = lds_byte(wc * 32 + fr, fq * 8);
#define PG8_SA(b, h) (((b) * 2 + (h)) * HTB)
#define PG8_SB(b, h) ((4 + (b) * 2 + (h)) * HTB)
#define PG8_STAGE(bufoff, gbase, voff) do { _Pragma("unroll") for (int _i = 0; _i < 2; ++_i) \
        __builtin_amdgcn_global_load_lds((const unsigned*)((const char*)(gbase) + (voff)[_i]), (PG8_LAS unsigned*)(lds + (bufoff) + ldsw + _i * 8192), 16, 0, 0); } while (0)
#define PG8_LDA(dst, b, h) do { _Pragma("unroll") for (int m = 0; m < 4; ++m) _Pragma("unroll") for (int k = 0; k < 2; ++k) dst[m][k] = *(const PG8_LAS bf16x8*)(lds + PG8_SA(b, h) + aoff + m * 2048 + k * 1024); } while (0)
#define PG8_LDB(dst, b, h) do { _Pragma("unroll") for (int n = 0; n < 2; ++n) _Pragma("unroll") for (int k = 0; k < 2; ++k) dst[n][k] = *(const PG8_LAS bf16x8*)(lds + PG8_SB(b, h) + boff + n * 2048 + k * 1024); } while (0)
#define PG8_MMA(ai, bj, At, Bt) do { __builtin_amdgcn_s_setprio(1); _Pragma("unroll") for (int m = 0; m < 4; ++m) _Pragma("unroll") for (int n = 0; n < 2; ++n) _Pragma("unroll") for (int k = 0; k < 2; ++k) \
        acc[ai][bj][m][n] = __builtin_amdgcn_mfma_f32_16x16x32_bf16(Bt[n][k], At[m][k], acc[ai][bj][m][n], 0, 0, 0); __builtin_amdgcn_s_setprio(0); } while (0)
#define PG8_WAIT_V(n) asm volatile("s_waitcnt vmcnt(" #n ")" ::: "memory")
#define PG8_WAIT_L(n) asm volatile("s_waitcnt lgkmcnt(" #n ")" ::: "memory")
#define PG8_BAR __builtin_amdgcn_s_barrier()
#define PG8_SCHED __builtin_amdgcn_sched_barrier(0)
    Unit cur, nxt; int ui = 0;
    if (!S.next(0, cur)) return;
    f32x4 acc[2][2][4][2];
#pragma unroll
    for (int a = 0; a < 2; ++a)
#pragma unroll
        for (int b = 0; b < 2; ++b)
#pragma unroll
            for (int m = 0; m < 4; ++m)
#pragma unroll
                for (int n = 0; n < 2; ++n) acc[a][b][m][n] = (f32x4){0.f, 0.f, 0.f, 0.f};
    bf16x8 At[4][2], B0[2][2], B1[2][2];
    const char* cA = (const char*)g.A + (size_t)cur.pm * tstep; const char* cB = (const char*)g.Bt + (size_t)cur.pn * tstep;
    S.a_ready(cur);
    if constexpr (SP2) {
        PG8_STAGE(PG8_SB(0, 0), cB, voffB); PG8_STAGE(PG8_SB(0, 1), cB + hstep, voffB); PG8_STAGE(PG8_SA(0, 0), cA, voffA); PG8_STAGE(PG8_SA(0, 1), cA + hstep, voffA);
        if (wr == 1) PG8_BAR;
        PG8_WAIT_V(2); PG8_BAR;
        PG8_STAGE(PG8_SB(1, 0), cB + kstep, voffB); PG8_STAGE(PG8_SA(1, 0), cA + kstep, voffA); PG8_STAGE(PG8_SB(1, 1), cB + hstep + kstep, voffB);
        PG8_WAIT_V(6); PG8_BAR;
    } else {
        PG8_STAGE(PG8_SB(0, 0), cB, voffB); PG8_STAGE(PG8_SA(0, 0), cA, voffA); PG8_STAGE(PG8_SB(0, 1), cB + hstep, voffB); PG8_STAGE(PG8_SA(0, 1), cA + hstep, voffA);
        if (wr == 1) PG8_BAR;
        PG8_WAIT_V(4); PG8_BAR;
        PG8_STAGE(PG8_SB(1, 0), cB + kstep, voffB); PG8_STAGE(PG8_SA(1, 0), cA + kstep, voffA); PG8_STAGE(PG8_SB(1, 1), cB + hstep + kstep, voffB);
        PG8_WAIT_V(6); PG8_BAR;
    }
    for (;;) {
        const bool has_next = S.next(ui + 1, nxt);
        const char* nA = has_next ? (const char*)g.A + (size_t)nxt.pm * tstep : cA; const char* nB = has_next ? (const char*)g.Bt + (size_t)nxt.pn * tstep : cB;
        for (int t = 0; t < nt; t += 2) {
            const bool last = (t == nt - 2);
            const char* a1 = cA + (size_t)(t + 1) * kstep;
            const char* a2 = last ? nA : cA + (size_t)(t + 2) * kstep; const char* b2 = last ? nB : cB + (size_t)(t + 2) * kstep;
            const char* a3 = a2 + kstep; const char* b3 = b2 + kstep;
            if (last && has_next) S.a_ready(nxt);
            if constexpr (pg8_has_midk<Epi>::value) { if (t == nt / 2) { int z = t - nt / 2; asm volatile("" : "+s"(z)); E.mid(acc, cur, wr, wc, fr, fq, z); } }
            if constexpr (SP2) {
            PG8_LDB(B0, 0, 0); PG8_LDB(B1, 0, 1); PG8_SCHED; PG8_LDA(At, 0, 0); PG8_STAGE(PG8_SA(1, 1), a1 + hstep, voffA);
            PG8_WAIT_V(8); PG8_WAIT_L(0); PG8_BAR; PG8_MMA(0, 0, At, B0); PG8_MMA(0, 1, At, B1); PG8_BAR; PG8_SCHED;
            PG8_LDA(At, 0, 1); PG8_STAGE(PG8_SB(0, 0), b2, voffB); PG8_STAGE(PG8_SB(0, 1), b2 + hstep, voffB); PG8_STAGE(PG8_SA(0, 0), a2, voffA);
            PG8_WAIT_V(8); PG8_WAIT_L(0); PG8_BAR; PG8_MMA(1, 0, At, B0); PG8_MMA(1, 1, At, B1); PG8_BAR; PG8_SCHED;
            PG8_LDB(B0, 1, 0); PG8_LDB(B1, 1, 1); PG8_SCHED; PG8_LDA(At, 1, 0); PG8_STAGE(PG8_SA(0, 1), a2 + hstep, voffA);
            PG8_WAIT_V(8); PG8_WAIT_L(0); PG8_BAR; PG8_MMA(0, 0, At, B0); PG8_MMA(0, 1, At, B1); PG8_BAR; PG8_SCHED;
            PG8_LDA(At, 1, 1); PG8_STAGE(PG8_SB(1, 0), b3, voffB); PG8_STAGE(PG8_SB(1, 1), b3 + hstep, voffB); PG8_STAGE(PG8_SA(1, 0), a3, voffA);
            PG8_WAIT_V(8); PG8_WAIT_L(0); PG8_BAR; PG8_MMA(1, 0, At, B0); PG8_MMA(1, 1, At, B1); PG8_BAR; PG8_SCHED;
            } else {
            PG8_LDB(B0, 0, 0); PG8_SCHED; PG8_LDA(At, 0, 0); PG8_STAGE(PG8_SA(1, 1), a1 + hstep, voffA);
            PG8_WAIT_L(8); PG8_BAR; PG8_WAIT_L(0); PG8_MMA(0, 0, At, B0); PG8_BAR; PG8_SCHED;
            PG8_LDB(B1, 0, 1); PG8_STAGE(PG8_SB(0, 0), b2, voffB);
            PG8_BAR; PG8_WAIT_L(0); PG8_MMA(0, 1, At, B1); PG8_BAR;
            PG8_LDA(At, 0, 1); PG8_STAGE(PG8_SA(0, 0), a2, voffA);
            PG8_BAR; PG8_WAIT_L(0); PG8_MMA(1, 0, At, B0); PG8_BAR; PG8_SCHED;
            PG8_STAGE(PG8_SB(0, 1), b2 + hstep, voffB);
            PG8_WAIT_V(6); PG8_BAR; PG8_MMA(1, 1, At, B1); PG8_BAR;
            PG8_LDB(B0, 1, 0); PG8_SCHED; PG8_LDA(At, 1, 0); PG8_STAGE(PG8_SA(0, 1), a2 + hstep, voffA);
            PG8_WAIT_L(8); PG8_BAR; PG8_WAIT_L(0); PG8_MMA(0, 0, At, B0); PG8_BAR; PG8_SCHED;
            PG8_LDB(B1, 1, 1); PG8_STAGE(PG8_SB(1, 0), b3, voffB);
            PG8_BAR; PG8_WAIT_L(0); PG8_MMA(0, 1, At, B1); PG8_BAR;
            PG8_LDA(At, 1, 1); PG8_STAGE(PG8_SA(1, 0), a3, voffA);
            PG8_BAR; PG8_WAIT_L(0); PG8_MMA(1, 0, At, B0); PG8_BAR; PG8_SCHED;
            PG8_STAGE(PG8_SB(1, 1), b3 + hstep, voffB);
            PG8_WAIT_V(6); PG8_BAR; PG8_MMA(1, 1, At, B1); PG8_BAR;
            }
        }
        if constexpr (ALIGN_EPI) { if (wr == 0) PG8_BAR; }
        if constexpr (!Epi::AFTER_DRAIN) { E(acc, cur, wr, wc, fr, fq); S.done(cur); }
        if (!has_next) break;
#pragma unroll
        for (int a = 0; a < 2; ++a)
#pragma unroll
            for (int b = 0; b < 2; ++b)
#pragma unroll
                for (int m = 0; m < 4; ++m)
#pragma unroll
                    for (int n = 0; n < 2; ++n) acc[a][b][m][n] = (f32x4){0.f, 0.f, 0.f, 0.f};
        cur = nxt; cA = nA; cB = nB; ++ui;
        if constexpr (ALIGN_EPI) { if (wr == 1) PG8_BAR; }
    }
    PG8_WAIT_V(0);
    if constexpr (!ALIGN_EPI) { if (wr == 0) PG8_BAR; }
    PG8_BAR;
    if constexpr (Epi::AFTER_DRAIN) { E.fused(acc, cur, wr, wc, fr, fq, lds, wid, lane); S.done(cur); }
#undef PG8_SA
#undef PG8_SB
#undef PG8_STAGE
#undef PG8_LDA
#undef PG8_LDB
#undef PG8_MMA
#undef PG8_WAIT_V
#undef PG8_WAIT_L
#undef PG8_BAR
#undef PG8_SCHED
}
}
#define XB_TMO      128
#define XB_XCNT(j)  (256  + 64 * (j))
#define XB_XSUB(j)  (1280 + 64 * (j))
#define XB_XGEN(j)  (2304 + 64 * (j))
#define XB_TOP      3328
#define XB_TOPGEN   3392
#define XCD_BAR_WORDS 3456
#define XB_SPIN_CAP (1u << 18)
#define LAS __attribute__((address_space(3)))

__device__ __forceinline__ unsigned xb_ld(unsigned* p)              { return __hip_atomic_load(p, __ATOMIC_RELAXED, __HIP_MEMORY_SCOPE_AGENT); }
__device__ __forceinline__ unsigned xb_add(unsigned* p, unsigned v) { return __hip_atomic_fetch_add(p, v, __ATOMIC_RELAXED, __HIP_MEMORY_SCOPE_AGENT); }
__device__ __forceinline__ unsigned xb_xcc_id() { return (unsigned)__builtin_amdgcn_s_getreg((3 << 11) | 20) & 0xFu; }
#define XB_SPIN(cond, bar) do { unsigned _sp = 0; while (cond) { __builtin_amdgcn_s_sleep(1); \
    if ((++_sp & 255u) == 0u) { if (xb_ld(&(bar)[XB_TMO])) break; if (_sp > XB_SPIN_CAP) { atomicAdd(&(bar)[XB_TMO], 1u); break; } } } } while (0)

struct XcdBarrier {
    unsigned* bar; unsigned x;
    volatile LAS unsigned* st;
};

__device__ __forceinline__ XcdBarrier xcd_barrier_post(unsigned* bar, volatile LAS unsigned* st) {
    XcdBarrier b; b.bar = bar; b.x = xb_xcc_id(); b.st = st;
    if (threadIdx.x == 0) (void)xb_add(&bar[XB_XCNT(b.x)], 1u);
    return b;
}
__device__ __forceinline__ void xcd_barrier_complete(unsigned* bar, unsigned x, unsigned& nloc, unsigned& nx) {
    const unsigned G = gridDim.x * gridDim.y * gridDim.z;
    unsigned sum, cnt, mine, sp = 0u;
    for (;;) {
        sum = 0u; cnt = 0u; mine = 0u;
#pragma unroll
        for (unsigned j = 0; j < 16; ++j) { const unsigned c = xb_ld(&bar[XB_XCNT(j)]); sum += c; cnt += (c > 0u) ? 1u : 0u; mine = (j == x) ? c : mine; }
        if (sum == G) break;
        __builtin_amdgcn_s_sleep(1);
        if ((++sp & 255u) == 0u) { if (xb_ld(&bar[XB_TMO])) break; if (sp > XB_SPIN_CAP) { atomicAdd(&bar[XB_TMO], 1u); break; } }
    }
    nloc = mine > 0u ? mine : 1u; nx = cnt > 0u ? cnt : 1u;
}

__device__ __forceinline__ void xcd_barrier(const XcdBarrier& b) {
    asm volatile("s_waitcnt vmcnt(0)" ::: "memory");
    __syncthreads();
    if (threadIdx.x == 0) {
        unsigned* bar = b.bar;
        __builtin_amdgcn_s_waitcnt(0);
        unsigned nloc = b.st[0], nx = b.st[1];
        if (nloc == 0u) { xcd_barrier_complete(bar, b.x, nloc, nx); b.st[0] = nloc; b.st[1] = nx; }
        const unsigned old = xb_add(&bar[XB_XSUB(b.x)], 1u);
        const unsigned gen = old / nloc;
        if (old + 1u == (gen + 1u) * nloc) {
            __builtin_amdgcn_fence(__ATOMIC_RELEASE, "agent");
            asm volatile("s_waitcnt vmcnt(0)" ::: "memory");
            const unsigned og = xb_add(&bar[XB_TOP], 1u);
            const unsigned tg = og / nx;
            if (og + 1u == (tg + 1u) * nx) xb_add(&bar[XB_TOPGEN], 1u);
            else XB_SPIN(xb_ld(&bar[XB_TOPGEN]) == tg, bar);
            __builtin_amdgcn_fence(__ATOMIC_ACQUIRE, "agent");
            xb_add(&bar[XB_XGEN(b.x)], 1u);
            asm volatile("s_waitcnt vmcnt(0)" ::: "memory");
        } else {
            XB_SPIN(xb_ld(&bar[XB_XGEN(b.x)]) == gen, bar);
            __builtin_amdgcn_fence(__ATOMIC_ACQUIRE, "agent");
            asm volatile("s_waitcnt vmcnt(0)" ::: "memory");
        }
    }
    __syncthreads();
}

__device__ __forceinline__ void xcd_barrier_arrive(const XcdBarrier& b) {
    asm volatile("s_waitcnt vmcnt(0)" ::: "memory");
    __syncthreads();
    if (threadIdx.x == 0) {
        unsigned* bar = b.bar;
        __builtin_amdgcn_s_waitcnt(0);
        unsigned nloc = b.st[0], nx = b.st[1];
        if (nloc == 0u) { xcd_barrier_complete(bar, b.x, nloc, nx); b.st[0] = nloc; b.st[1] = nx; }
        const unsigned old = xb_add(&bar[XB_XSUB(b.x)], 1u);
        const unsigned gen = old / nloc;
        if (old + 1u == (gen + 1u) * nloc) {
            __builtin_amdgcn_fence(__ATOMIC_RELEASE, "agent");
            asm volatile("s_waitcnt vmcnt(0)" ::: "memory");
            const unsigned og = xb_add(&bar[XB_TOP], 1u);
            const unsigned tg = og / nx;
            if (og + 1u == (tg + 1u) * nx) xb_add(&bar[XB_TOPGEN], 1u);
            else XB_SPIN(xb_ld(&bar[XB_TOPGEN]) == tg, bar);
            __builtin_amdgcn_fence(__ATOMIC_ACQUIRE, "agent");
            xb_add(&bar[XB_XGEN(b.x)], 1u);
            asm volatile("s_waitcnt vmcnt(0)" ::: "memory");
            b.st[2] = 0u;
        } else { b.st[2] = 1u; b.st[3] = gen; }
    }
}
__device__ __forceinline__ void xcd_barrier_wait(const XcdBarrier& b) {
    if (threadIdx.x == 0) {
        if (b.st[2] != 0u) {
            unsigned* bar = b.bar; const unsigned gen = b.st[3];
            XB_SPIN(xb_ld(&bar[XB_XGEN(b.x)]) == gen, bar);
            __builtin_amdgcn_fence(__ATOMIC_ACQUIRE, "agent");
            asm volatile("s_waitcnt vmcnt(0)" ::: "memory");
            b.st[2] = 0u;
        }
    }
    __syncthreads();
}


typedef float f32x4 __attribute__((ext_vector_type(4)));
typedef float f32x2 __attribute__((ext_vector_type(2)));
typedef _Float16 lf_t;
typedef _Float16 lf_x4 __attribute__((ext_vector_type(4)));
__device__ __forceinline__ float wave_sum(float v) {
#pragma unroll
    for (int o = 1; o < 64; o <<= 1) v += __shfl_xor(v, o);
    return v;
}
__device__ __forceinline__ float wave_max(float v) {
#pragma unroll
    for (int o = 1; o < 64; o <<= 1) v = fmaxf(v, __shfl_xor(v, o));
    return v;
}
__device__ __forceinline__ float fexp2(float x) { return __builtin_amdgcn_exp2f(x); }
__device__ __forceinline__ float fexp(float x) { return __builtin_amdgcn_exp2f(x * 1.4426950408889634f); }
__device__ __forceinline__ float flog2(float x) { return __builtin_amdgcn_logf(x); }
__device__ __forceinline__ float frcp(float x) { return __builtin_amdgcn_rcpf(x); }
__device__ __forceinline__ float frsq(float x) { return __builtin_amdgcn_rsqf(x); }
__device__ __forceinline__ float sigmoidf_(float x) { return frcp(1.0f + fexp(-x)); }
__device__ __forceinline__ float siluf_(float x) { return x * frcp(1.0f + fexp(-x)); }
__device__ __forceinline__ int seq_of_row(int r) { return r < MP ? r / TP : NP + (r - MP) / TS; }
typedef __bf16 hwbf2 __attribute__((ext_vector_type(2)));
__device__ __forceinline__ unsigned f2bf(float f) { return (unsigned)__builtin_bit_cast(unsigned short, (__bf16)f); }
__device__ __forceinline__ unsigned pk2(float lo, float hi) { hwbf2 v; v[0] = (__bf16)lo; v[1] = (__bf16)hi; return __builtin_bit_cast(unsigned, v); }
__host__ __device__ __forceinline__ int phys_row(int n) { return (n & ~255) + ((n >> 5) & 1) * 128 + ((n >> 6) & 3) * 32 + (n & 31); }

__device__ __forceinline__ float bf2f(unsigned short b) { return __builtin_bit_cast(float, (unsigned)b << 16); }
__device__ __forceinline__ float bflo(unsigned w) { return __builtin_bit_cast(float, w << 16); }
__device__ __forceinline__ float bfhi(unsigned w) { return __builtin_bit_cast(float, w & 0xffff0000u); }
struct EpiIn {
    static constexpr bool PERM = true, AFTER_DRAIN = false;
    unsigned char* ws; bf16 *QA, *KA, *VA; _Float16* LF; float* out; const float* q_gain; const float* k_gain; const float* LB;
    __device__ __forceinline__ void operator()(const pg8::f32x4 (&acc)[2][2][4][2], const pg8::Unit& u, int wr, int wc, int fr, int fq) const {
        const int row0 = u.pm * 256 + wr * 64 + fr, pn = u.pn, cw = wc * 64 + fq * 8;
        if (pn < 12) {
            const bool isk = pn >= 6; const int hd = (isk ? pn - 6 : pn) * 4 + wc, g = hd >> 3, j = hd & 7;
            const float* gp = (isk ? k_gain : q_gain) + fq * 8;
            float gn[2][2][4];
#pragma unroll
            for (int bj = 0; bj < 2; ++bj)
#pragma unroll
                for (int n = 0; n < 2; ++n) { const pg8::f32x4 t = *(const pg8::f32x4*)(gp + bj * 32 + n * 4);
#pragma unroll
                    for (int jj = 0; jj < 4; ++jj) gn[bj][n][jj] = t[jj] * (isk ? 1.0f : QSCALE); }
            const int W = g == 0 ? 128 : (g == 1 ? 512 : 2048);
            const size_t okvp = g == 0 ? O_KVP0 : (g == 1 ? O_KVP1 : O_KVP2), okvs = g == 0 ? O_KVS0 : (g == 1 ? O_KVS1 : O_KVS2);
#pragma unroll
            for (int ai = 0; ai < 2; ++ai)
#pragma unroll
                for (int m = 0; m < 4; ++m) { const int row = row0 + ai * 128 + m * 16;
                    float ss = 0.f;
#pragma unroll
                    for (int bj = 0; bj < 2; ++bj)
#pragma unroll
                        for (int n = 0; n < 2; ++n) { const pg8::f32x4 v = acc[ai][bj][m][n]; ss += (v[0] * v[0] + v[1] * v[1]) + (v[2] * v[2] + v[3] * v[3]); }
                    ss += __shfl_xor(ss, 16); ss += __shfl_xor(ss, 32);
                    const float rstd = frsq(ss * (1.0f / 64.f) + EPS);
                    float* kvd = nullptr;
                    if (isk) { if (row < MP) { const int nn = row / TP, t = row % TP; if (t >= TP - W) kvd = out + okvp + ((size_t)nn * W + (t - (TP - W))) * 1024 + j * 64 + fq * 8; }
                               else kvd = out + okvs + (size_t)(row - MP) * 1024 + j * 64 + fq * 8; }
                    bf16* dst = (isk ? KA : QA) + (size_t)row * 1536 + hd * 64 + fq * 8;
#pragma unroll
                    for (int bj = 0; bj < 2; ++bj) { float o[8];
#pragma unroll
                        for (int n = 0; n < 2; ++n)
#pragma unroll
                            for (int jj = 0; jj < 4; ++jj) o[n * 4 + jj] = acc[ai][bj][m][n][jj] * rstd * gn[bj][n][jj];
                        v4u w; w.x = pk2(o[0], o[1]); w.y = pk2(o[2], o[3]); w.z = pk2(o[4], o[5]); w.w = pk2(o[6], o[7]);
                        *(v4u*)(dst + bj * 32) = w;
                        if (kvd) { *(pg8::f32x4*)(kvd + bj * 32) = (pg8::f32x4){o[0], o[1], o[2], o[3]}; *(pg8::f32x4*)(kvd + bj * 32 + 4) = (pg8::f32x4){o[4], o[5], o[6], o[7]}; } } }
        } else if (pn < 18) {
            const int hd = (pn - 12) * 4 + wc, g = hd >> 3, j = hd & 7;
            const int W = g == 0 ? 128 : (g == 1 ? 512 : 2048);
            const size_t okvp = g == 0 ? O_KVP0 : (g == 1 ? O_KVP1 : O_KVP2), okvs = g == 0 ? O_KVS0 : (g == 1 ? O_KVS1 : O_KVS2);
#pragma unroll
            for (int ai = 0; ai < 2; ++ai)
#pragma unroll
                for (int m = 0; m < 4; ++m) { const int row = row0 + ai * 128 + m * 16;
                    float* kvd = nullptr;
                    if (row < MP) { const int nn = row / TP, t = row % TP; if (t >= TP - W) kvd = out + okvp + ((size_t)nn * W + (t - (TP - W))) * 1024 + 512 + j * 64 + fq * 8; }
                    else kvd = out + okvs + (size_t)(row - MP) * 1024 + 512 + j * 64 + fq * 8;
                    bf16* dst = VA + (size_t)row * 1536 + hd * 64 + fq * 8;
#pragma unroll
                    for (int bj = 0; bj < 2; ++bj) { const pg8::f32x4 a0 = acc[ai][bj][m][0], a1 = acc[ai][bj][m][1];
                        v4u w; w.x = pk2(a0[0], a0[1]); w.y = pk2(a0[2], a0[3]); w.z = pk2(a1[0], a1[1]); w.w = pk2(a1[2], a1[3]);
                        *(v4u*)(dst + bj * 32) = w;
                        if (kvd) { *(pg8::f32x4*)(kvd + bj * 32) = a0; *(pg8::f32x4*)(kvd + bj * 32 + 4) = a1; } } }
        } else if (pn >= 22 && pn < 24) {
            const int c0 = (pn - 22) * 256 + cw;
            float lb[2][2][4];
#pragma unroll
            for (int bj = 0; bj < 2; ++bj)
#pragma unroll
                for (int n = 0; n < 2; ++n) { const pg8::f32x4 t = *(const pg8::f32x4*)(LB + c0 + bj * 32 + n * 4);
#pragma unroll
                    for (int jj = 0; jj < 4; ++jj) lb[bj][n][jj] = t[jj]; }
#pragma unroll
            for (int ai = 0; ai < 2; ++ai)
#pragma unroll
                for (int m = 0; m < 4; ++m) { const int row = row0 + ai * 128 + m * 16;
#pragma unroll
                    for (int bj = 0; bj < 2; ++bj)
#pragma unroll
                        for (int n = 0; n < 2; ++n) { pg8::f32x4 o;
#pragma unroll
                            for (int jj = 0; jj < 4; ++jj) o[jj] = flog2(lb[bj][n][jj] + (1.f - lb[bj][n][jj]) * sigmoidf_(acc[ai][bj][m][n][jj]));
                            { typedef _Float16 h4_t __attribute__((ext_vector_type(4))); *(h4_t*)(LF + (size_t)row * 512 + c0 + bj * 32 + n * 4) = (h4_t){(_Float16)o[0], (_Float16)o[1], (_Float16)o[2], (_Float16)o[3]}; } } }
        } else {
            size_t woff; int ld, c0, act;
            if (pn < 20) { woff = WS_ZA; ld = 512; c0 = (pn - 18) * 256; act = 1; }
            else if (pn < 22) { woff = WS_QB; ld = 512; c0 = (pn - 20) * 256; act = 1; }
            else if (pn < 26) { woff = WS_IB; ld = 512; c0 = (pn - 24) * 256; act = 0; }
            else if (pn < 28) { woff = WS_ZB; ld = 512; c0 = (pn - 26) * 256; act = 1; }
            else if (pn < 32) { woff = WS_GA; ld = 1024; c0 = (pn - 28) * 256; act = 2; }
            else { woff = WS_GB; ld = 1024; c0 = (pn - 32) * 256; act = 2; }
            bf16* base = (bf16*)(ws + woff);
#pragma unroll
            for (int ai = 0; ai < 2; ++ai)
#pragma unroll
                for (int m = 0; m < 4; ++m) { const int row = row0 + ai * 128 + m * 16;
#pragma unroll
                    for (int bj = 0; bj < 2; ++bj) { float o[8];
#pragma unroll
                        for (int n = 0; n < 2; ++n)
#pragma unroll
                            for (int jj = 0; jj < 4; ++jj) { const float x = acc[ai][bj][m][n][jj]; const float sg = frcp(1.0f + fexp(-x)); o[n * 4 + jj] = act == 0 ? x : (act == 1 ? x * sg : sg); }
                        v4u w; w.x = pk2(o[0], o[1]); w.y = pk2(o[2], o[3]); w.z = pk2(o[4], o[5]); w.w = pk2(o[6], o[7]);
                        *(v4u*)(base + (size_t)row * ld + c0 + cw + bj * 32) = w; } }
        }
    }
};
__device__ __forceinline__ float gfl(float g) { return fmaxf(g, 1e-18f); }
struct EpiG2 {
    static constexpr bool PERM = true, AFTER_DRAIN = false, MIDK = true; const bf16* GA; const bf16* GB; bf16* MG;
    __device__ __forceinline__ void mid(pg8::f32x4 (&acc)[2][2][4][2], const pg8::Unit& u, int wr, int wc, int fr, int fq, int z) const {
        const int row0 = u.pm * 256 + wr * 64 + fr + z, lc0 = u.pn * 256 + wc * 64 + fq * 8;
#pragma unroll
        for (int ai = 0; ai < 2; ++ai) {
            v4u ga[4][2], gb[4][2];
#pragma unroll
            for (int m = 0; m < 4; ++m)
#pragma unroll
                for (int bj = 0; bj < 2; ++bj) { const size_t o = (size_t)(row0 + ai * 128 + m * 16) * D + lc0 + bj * 32; ga[m][bj] = *(const v4u*)(GA + o); gb[m][bj] = *(const v4u*)(GB + o); }
#pragma unroll
            for (int m = 0; m < 4; ++m)
#pragma unroll
                for (int bj = 0; bj < 2; ++bj) { const v4u a = ga[m][bj], b = gb[m][bj];
                    acc[ai][bj][m][0][0] *= bflo(a.x) * frcp(gfl(bflo(b.x))); acc[ai][bj][m][0][1] *= bfhi(a.x) * frcp(gfl(bfhi(b.x)));
                    acc[ai][bj][m][0][2] *= bflo(a.y) * frcp(gfl(bflo(b.y))); acc[ai][bj][m][0][3] *= bfhi(a.y) * frcp(gfl(bfhi(b.y)));
                    acc[ai][bj][m][1][0] *= bflo(a.z) * frcp(gfl(bflo(b.z))); acc[ai][bj][m][1][1] *= bfhi(a.z) * frcp(gfl(bfhi(b.z)));
                    acc[ai][bj][m][1][2] *= bflo(a.w) * frcp(gfl(bflo(b.w))); acc[ai][bj][m][1][3] *= bfhi(a.w) * frcp(gfl(bfhi(b.w))); }
            asm volatile("" ::: "memory");
        }
    }
    __device__ __forceinline__ void operator()(const pg8::f32x4 (&acc)[2][2][4][2], const pg8::Unit& u, int wr, int wc, int fr, int fq) const {
        const int row0 = u.pm * 256 + wr * 64 + fr, lc0 = u.pn * 256 + wc * 64 + fq * 8;
#pragma unroll
        for (int ai = 0; ai < 2; ++ai) {
            v4u gq[4][2];
#pragma unroll
            for (int m = 0; m < 4; ++m)
#pragma unroll
                for (int bj = 0; bj < 2; ++bj) gq[m][bj] = *(const v4u*)(GB + (size_t)(row0 + ai * 128 + m * 16) * D + lc0 + bj * 32);
#pragma unroll
            for (int m = 0; m < 4; ++m) { const int row = row0 + ai * 128 + m * 16;
#pragma unroll
                for (int bj = 0; bj < 2; ++bj) { const int c = lc0 + bj * 32; const v4u g = gq[m][bj];
                    const pg8::f32x4 a0 = acc[ai][bj][m][0], a1 = acc[ai][bj][m][1];
                    v4u w; w.x = pk2(gfl(bflo(g.x)) * a0[0], gfl(bfhi(g.x)) * a0[1]); w.y = pk2(gfl(bflo(g.y)) * a0[2], gfl(bfhi(g.y)) * a0[3]);
                    w.z = pk2(gfl(bflo(g.z)) * a1[0], gfl(bfhi(g.z)) * a1[1]); w.w = pk2(gfl(bflo(g.w)) * a1[2], gfl(bfhi(g.w)) * a1[3]);
                    *(v4u*)(MG + (size_t)row * D + c) = w; } }
        }
    }
};
struct EpiY {
    static constexpr bool PERM = true, AFTER_DRAIN = false; float* out; const float* xp; const float* xs; const float* ada;
    __device__ __forceinline__ void operator()(const pg8::f32x4 (&acc)[2][2][4][2], const pg8::Unit& u, int wr, int wc, int fr, int fq) const {
        const int row0 = u.pm * 256 + wr * 64 + fr, lc0 = u.pn * 256 + wc * 64 + fq * 8;
        if (u.pm < MP / 256) {
            const float* gr = ada + (size_t)((u.pm * 256) / TP) * 3072 + 2048;
            pg8::f32x4 gv[2][2];
#pragma unroll
            for (int bj = 0; bj < 2; ++bj)
#pragma unroll
                for (int n = 0; n < 2; ++n) gv[bj][n] = *(const pg8::f32x4*)(gr + lc0 + bj * 32 + n * 4);
#pragma unroll
            for (int ai = 0; ai < 2; ++ai) {
                pg8::f32x4 xv[4][2][2];
#pragma unroll
                for (int m = 0; m < 4; ++m) { const float* xr = xp + (size_t)(row0 + ai * 128 + m * 16) * D;
#pragma unroll
                    for (int bj = 0; bj < 2; ++bj)
#pragma unroll
                        for (int n = 0; n < 2; ++n) xv[m][bj][n] = *(const pg8::f32x4*)(xr + lc0 + bj * 32 + n * 4); }
#pragma unroll
                for (int m = 0; m < 4; ++m) { float* orow = out + O_YP + (size_t)(row0 + ai * 128 + m * 16) * D;
#pragma unroll
                    for (int bj = 0; bj < 2; ++bj)
#pragma unroll
                        for (int n = 0; n < 2; ++n) *(pg8::f32x4*)(orow + lc0 + bj * 32 + n * 4) = xv[m][bj][n] + gv[bj][n] * acc[ai][bj][m][n]; }
            }
            return;
        }
#pragma unroll
        for (int am = 0; am < 4; ++am) {
            const int ai = am >> 1;
            pg8::f32x4 xv[2][2][2], gv[2][2][2];
#pragma unroll
            for (int mm = 0; mm < 2; ++mm) { const int m = 2 * (am & 1) + mm, row = row0 + ai * 128 + m * 16; const int sq = seq_of_row(row);
                const float* xr = row < MP ? xp + (size_t)row * D : xs + (size_t)(row - MP) * D;
                const float* gr = ada + (size_t)sq * 3072 + 2048;
#pragma unroll
                for (int bj = 0; bj < 2; ++bj)
#pragma unroll
                    for (int n = 0; n < 2; ++n) { const int c = lc0 + bj * 32 + n * 4; gv[mm][bj][n] = *(const pg8::f32x4*)(gr + c); xv[mm][bj][n] = *(const pg8::f32x4*)(xr + c); } }
#pragma unroll
            for (int mm = 0; mm < 2; ++mm) { const int m = 2 * (am & 1) + mm, row = row0 + ai * 128 + m * 16;
                float* orow = out + (row < MP ? O_YP + (size_t)row * D : O_YS + (size_t)(row - MP) * D);
#pragma unroll
                for (int bj = 0; bj < 2; ++bj)
#pragma unroll
                    for (int n = 0; n < 2; ++n) { const int c = lc0 + bj * 32 + n * 4; *(pg8::f32x4*)(orow + c) = xv[mm][bj][n] + gv[mm][bj][n] * acc[ai][bj][m][n]; } }
        }
    }
};

__device__ __forceinline__ void p0_transpose_item(const float* W, int K, int N, bf16* WT, LAS float* scr, int item, int lane, int ldk = 0) {
    const int nblk = N / 32, kb = item / nblk, nb = item % nblk, k0 = 64 * kb, n0 = 32 * nb;
    float wv[32];
#pragma unroll
    for (int i = 0; i < 32; ++i) wv[i] = W[(size_t)(k0 + 2 * i + (lane >> 5)) * N + n0 + (lane & 31)];
#pragma unroll
    for (int i = 0; i < 32; ++i) scr[(2 * i + (lane >> 5)) * 33 + (lane & 31)] = wv[i];
    asm volatile("s_waitcnt lgkmcnt(0)" ::: "memory");
    const int c = lane & 7;
    const int pr0 = phys_row(n0);
#pragma unroll
    for (int j = 0; j < 4; ++j) { const int n = (lane >> 3) + 8 * j; const LAS float* s = scr + (8 * c) * 33 + n;
        v4u o; o.x = pk2(s[0 * 33], s[1 * 33]); o.y = pk2(s[2 * 33], s[3 * 33]); o.z = pk2(s[4 * 33], s[5 * 33]); o.w = pk2(s[6 * 33], s[7 * 33]);
        *(v4u*)(WT + (size_t)(pr0 + n) * (ldk ? ldk : K) + k0 + 8 * c) = o; }
    asm volatile("s_waitcnt lgkmcnt(0)" ::: "memory");
}


typedef short bf16x8 __attribute__((ext_vector_type(8)));
typedef short s16x4 __attribute__((ext_vector_type(4)));
typedef float f32x16 __attribute__((ext_vector_type(16)));
constexpr int AT_PITCH = 144;
constexpr int AT_KEYS = 384, AT_VOFF = AT_KEYS * AT_PITCH;
constexpr int N_ATT_UNITS = 3 * NP * 8 * 16;
template <int O0, int O1> __device__ __forceinline__ bf16x8 tr_read2(unsigned addr) {
    s16x4 a0, a1;
    asm volatile("ds_read_b64_tr_b16 %0, %2 offset:%3\n\tds_read_b64_tr_b16 %1, %2 offset:%4\n\ts_waitcnt lgkmcnt(0)" : "=&v"(a0), "=&v"(a1) : "v"(addr), "i"(O0), "i"(O1) : "memory");
    return (bf16x8){a0[0], a0[1], a0[2], a0[3], a1[0], a1[1], a1[2], a1[3]};
}
struct TrQuad { bf16x8 a, b, c, d; };
template <int A0, int A1, int B0, int B1, int C0, int C1, int D0, int D1> __device__ __forceinline__ TrQuad tr_read8(unsigned addr) {
    s16x4 r0, r1, r2, r3, r4, r5, r6, r7;
    asm volatile("ds_read_b64_tr_b16 %0, %8 offset:%9\n\tds_read_b64_tr_b16 %1, %8 offset:%10\n\tds_read_b64_tr_b16 %2, %8 offset:%11\n\tds_read_b64_tr_b16 %3, %8 offset:%12\n\t"
                 "ds_read_b64_tr_b16 %4, %8 offset:%13\n\tds_read_b64_tr_b16 %5, %8 offset:%14\n\tds_read_b64_tr_b16 %6, %8 offset:%15\n\tds_read_b64_tr_b16 %7, %8 offset:%16\n\ts_waitcnt lgkmcnt(0)"
                 : "=&v"(r0), "=&v"(r1), "=&v"(r2), "=&v"(r3), "=&v"(r4), "=&v"(r5), "=&v"(r6), "=&v"(r7)
                 : "v"(addr), "i"(A0), "i"(A1), "i"(B0), "i"(B1), "i"(C0), "i"(C1), "i"(D0), "i"(D1) : "memory");
    TrQuad q;
    q.a = (bf16x8){r0[0], r0[1], r0[2], r0[3], r1[0], r1[1], r1[2], r1[3]}; q.b = (bf16x8){r2[0], r2[1], r2[2], r2[3], r3[0], r3[1], r3[2], r3[3]};
    q.c = (bf16x8){r4[0], r4[1], r4[2], r4[3], r5[0], r5[1], r5[2], r5[3]}; q.d = (bf16x8){r6[0], r6[1], r6[2], r6[3], r7[0], r7[1], r7[2], r7[3]};
    return q;
}
__device__ __forceinline__ void attn_prompt_unit(LAS unsigned char* lds, int u, const bf16* QA, const bf16* KA, const bf16* VA, bf16* OG, float* LSE, int tid, int wave, int lane) {
    const int g = u >> 9, rem = u & 511, n = rem >> 7, j = (rem >> 4) & 7, rq = rem & 15;
    const int dsh = 2 * g, d = 1 << dsh, qsh = 4 - dsh;
    const int r = rq >> qsh, qb = rq & ((1 << qsh) - 1);
    const int hd = g * 8 + j, kbase = 256 * qb - 128;
    const size_t nrow0 = (size_t)n * TP + r;
    __syncthreads();
#pragma unroll
    for (int i = 0; i < 6; ++i) {
        const int c = tid + 512 * i, key = c >> 3, ch = c & 7, pos = kbase + key;
        v4u kv = (v4u){0u, 0u, 0u, 0u}, vv = (v4u){0u, 0u, 0u, 0u};
        if (pos >= 0) { const size_t off = (nrow0 + (size_t)pos * d) * 1536 + hd * 64 + ch * 8; kv = *(const v4u*)(KA + off); vv = *(const v4u*)(VA + off); }
        *(LAS v4u*)(lds + key * AT_PITCH + ch * 16) = kv; *(LAS v4u*)(lds + AT_VOFF + key * AT_PITCH + ch * 16) = vv;
    }
    const int ql = lane & 31, h = lane >> 5, q0base = 256 * qb + 32 * wave;
    const size_t qrow = nrow0 + (size_t)(q0base + ql) * d;
    bf16x8 qf[4];
#pragma unroll
    for (int s4 = 0; s4 < 4; ++s4) qf[s4] = *(const bf16x8*)(QA + qrow * 1536 + hd * 64 + 16 * s4 + 8 * h);
    __syncthreads();
    const int keyi = (ql & ~0xC) | ((ql & 4) << 1) | ((ql & 8) >> 1);
    f32x16 S[5];
#pragma unroll
    for (int kt = 0; kt < 5; ++kt) {
        const LAS unsigned char* kp = lds + (32 * wave + 32 * kt + keyi) * AT_PITCH + 16 * h;
        f32x16 acc;
#pragma unroll
        for (int e = 0; e < 16; ++e) acc[e] = 0.f;
#pragma unroll
        for (int s4 = 0; s4 < 4; ++s4) { const bf16x8 kf = *(const LAS bf16x8*)(kp + 32 * s4); acc = __builtin_amdgcn_mfma_f32_32x32x16_bf16(kf, qf[s4], acc, 0, 0, 0); }
        S[kt] = acc;
    }
    const float slope2d = exp2f(-8.0f * (float)(hd + 1) / 24.0f) * LOG2E * (float)d;
    const float qh = (float)(ql - 8 * h);
    float mx = -INFINITY;
#pragma unroll
    for (int kt = 0; kt < 5; ++kt) {
        const bool tile_ok = !(qb == 0 && wave + kt < 4);
#pragma unroll
        for (int e = 0; e < 16; ++e) {
            const int kk0 = (e & 3) + 4 * ((e >> 2) & 1) + 16 * (e >> 3);
            float v = S[kt][e] - slope2d * (qh + (float)(128 - 32 * kt - kk0));
            bool ok = tile_ok;
            if (kt == 0) ok = ok && ((float)kk0 >= qh);
            if (kt == 4) ok = ok && ((float)kk0 <= qh);
            v = ok ? v : -INFINITY;
            S[kt][e] = v; mx = fmaxf(mx, v);
        }
    }
    mx = fmaxf(mx, __shfl_xor(mx, 32));
    float l = 0.f;
#pragma unroll
    for (int kt = 0; kt < 5; ++kt)
#pragma unroll
        for (int e = 0; e < 16; ++e) { const float pv = fexp2(S[kt][e] - mx); S[kt][e] = pv; l += pv; }
    l += __shfl_xor(l, 32);
    const float inv = frcp(l);
    f32x16 O[2];
#pragma unroll
    for (int mt = 0; mt < 2; ++mt)
#pragma unroll
        for (int e = 0; e < 16; ++e) O[mt][e] = 0.f;
    const unsigned vb = (unsigned)(size_t)(lds + AT_VOFF) + (unsigned)(((lane & 15) >> 2) * AT_PITCH + (16 * ((lane >> 4) & 1) + 4 * (lane & 3)) * 2 + 8 * h * AT_PITCH + 32 * wave * AT_PITCH);
#pragma unroll
    for (int kt = 0; kt < 5; ++kt) {
        const TrQuad vq = tr_read8<0, 4 * AT_PITCH, 64, 4 * AT_PITCH + 64, 16 * AT_PITCH, 20 * AT_PITCH, 16 * AT_PITCH + 64, 20 * AT_PITCH + 64>(vb + 32 * kt * AT_PITCH);
#pragma unroll
        for (int sp = 0; sp < 2; ++sp) {
            v4u pw;
            pw.x = pk2(S[kt][8 * sp + 0] * inv, S[kt][8 * sp + 1] * inv); pw.y = pk2(S[kt][8 * sp + 2] * inv, S[kt][8 * sp + 3] * inv);
            pw.z = pk2(S[kt][8 * sp + 4] * inv, S[kt][8 * sp + 5] * inv); pw.w = pk2(S[kt][8 * sp + 6] * inv, S[kt][8 * sp + 7] * inv);
            const bf16x8 pf = __builtin_bit_cast(bf16x8, pw);
            O[0] = __builtin_amdgcn_mfma_f32_32x32x16_bf16(sp ? vq.c : vq.a, pf, O[0], 0, 0, 0);
            O[1] = __builtin_amdgcn_mfma_f32_32x32x16_bf16(sp ? vq.d : vq.b, pf, O[1], 0, 0, 0);
        }
    }
    const size_t orow = (size_t)g * M + qrow;
    bf16* op = OG + orow * 512 + j * 64 + 4 * h;
#pragma unroll
    for (int mt = 0; mt < 2; ++mt)
#pragma unroll
        for (int e4 = 0; e4 < 4; ++e4) { v2u w; w.x = pk2(O[mt][4 * e4 + 0], O[mt][4 * e4 + 1]); w.y = pk2(O[mt][4 * e4 + 2], O[mt][4 * e4 + 3]); *(v2u*)(op + 32 * mt + 8 * e4) = w; }
    if (h == 0) LSE[orow * 8 + j] = mx + flog2(l);
}

__device__ __forceinline__ float dpp_row16_sum(float v) {
    v += __builtin_bit_cast(float, __builtin_amdgcn_update_dpp(0, __builtin_bit_cast(int, v), 0xB1, 0xF, 0xF, true));
    v += __builtin_bit_cast(float, __builtin_amdgcn_update_dpp(0, __builtin_bit_cast(int, v), 0x4E, 0xF, 0xF, true));
    v += __builtin_bit_cast(float, __builtin_amdgcn_update_dpp(0, __builtin_bit_cast(int, v), 0x141, 0xF, 0xF, true));
    v += __builtin_bit_cast(float, __builtin_amdgcn_update_dpp(0, __builtin_bit_cast(int, v), 0x140, 0xF, 0xF, true));
    return v;
}
constexpr int N_SAMP_ITEMS = NS * 8 * (1 + 4 + 8);
template <int G> __device__ __forceinline__ void attn_sample_item(LAS float* wl, int item, const bf16* QA, const float* cacheg, const float* kvs_out, bf16* OG, float* LSE, int lane) {
    constexpr int d = G == 0 ? 1 : (G == 1 ? 4 : 16), NQ = G == 0 ? 8 : (G == 1 ? 2 : 1), wb = G == 0 ? 128 : (G == 1 ? 512 : 2048), U = 128 + NQ, NR = d < 8 ? d : 8;
    constexpr int NIT = (U + 3) / 4;
    const int rho = item % NR, nj = item / NR, j = nj & 7, n = nj >> 3;
    const int ks = lane >> 4, c = lane & 15;
    const float* cg = cacheg + (size_t)n * wb * 1024 + j * 64 + 4 * c;
    const float* kn = kvs_out + (size_t)n * TS * 1024 + j * 64 + 4 * c;
    const float slope2d = exp2f(-8.0f * (float)(G * 8 + j + 1) / 24.0f) * LOG2E * (float)d;
    float4 qf[NQ];
    v2u qraw[NQ];
#pragma unroll
    for (int qi = 0; qi < NQ; ++qi) qraw[qi] = *(const v2u*)(QA + (size_t)(MP + n * TS + rho + d * qi) * 1536 + (G * 8 + j) * 64 + 4 * c);
    __builtin_amdgcn_sched_barrier(0);
#pragma unroll
    for (int qi = 0; qi < NQ; ++qi) qf[qi] = make_float4(bflo(qraw[qi].x), bfhi(qraw[qi].x), bflo(qraw[qi].y), bfhi(qraw[qi].y));
    LAS float* sc = wl;
    LAS float* pT = wl + 8 * 136;
    constexpr int NB = (NIT + 7) / 8;
    constexpr int RB = NQ == 1 ? 6 : 5, NBP = NQ == 1 ? 6 : 7;
    static_assert(NB == 5 && RB * NBP >= NIT, "sample attention batches");
    float4 ra[RB], rb[RB];
    const float* cbase = cg + (size_t)(rho + d * ks) * 1024;
    const float* nbase = kn + (size_t)(rho + d * ks) * 1024;
#define SA_LOAD(buf, b_, voff) do { _Pragma("unroll") for (int i = 0; i < RB; ++i) { \
        if (RB * (b_) + i < 32) buf[i] = *(const float4*)(cbase + (size_t)((4 * (RB * (b_) + i)) * d) * 1024 + (voff)); \
        else buf[i] = (4 * (RB * (b_) + i - 32) + ks < NQ) ? *(const float4*)(nbase + (size_t)(4 * (RB * (b_) + i - 32) * d) * 1024 + (voff)) : make_float4(0.f, 0.f, 0.f, 0.f); } \
        __builtin_amdgcn_sched_barrier(0); } while (0)
#define SA_SCORE(buf, b_) do { _Pragma("unroll") for (int i = 0; i < RB; ++i) { int u = 4 * ((b_) * RB + i) + ks; \
        asm volatile("" : "+v"(u));     \
        const float fu = (float)(u - 128); \
        _Pragma("unroll") for (int qi = 0; qi < NQ; ++qi) { \
            float dp = qf[qi].x * buf[i].x + qf[qi].y * buf[i].y + qf[qi].z * buf[i].z + qf[qi].w * buf[i].w; \
            dp = dpp_row16_sum(dp); \
            const bool ok = (u >= qi) && (u <= qi + 128); \
            const float v = ok ? fmaf(slope2d, fu - (float)qi, dp) : -INFINITY; \
            if (c == qi && u < 136) sc[qi * 136 + u] = v; } __builtin_amdgcn_sched_barrier(0); } } while (0)
#define SA_PV(buf, b_) do { _Pragma("unroll") for (int i = 0; i < RB; ++i) { const int u = 4 * ((b_) * RB + i) + ks; \
        _Pragma("unroll") for (int qi = 0; qi < NQ; ++qi) { const float pq = u < U ? pT[u * NQ + qi] : 0.f; \
            o[qi].x = fmaf(pq, buf[i].x, o[qi].x); o[qi].y = fmaf(pq, buf[i].y, o[qi].y); o[qi].z = fmaf(pq, buf[i].z, o[qi].z); o[qi].w = fmaf(pq, buf[i].w, o[qi].w); } \
        __builtin_amdgcn_sched_barrier(0); } } while (0)
    if constexpr (NQ == 1) {
    SA_LOAD(ra, 0, 0);
    SA_LOAD(rb, 1, 0); SA_SCORE(ra, 0);
    SA_LOAD(ra, 2, 0); SA_SCORE(rb, 1);
    SA_LOAD(rb, 3, 0); SA_SCORE(ra, 2);
    SA_LOAD(ra, 4, 0); SA_SCORE(rb, 3);
    SA_LOAD(rb, 5, 0); SA_SCORE(ra, 4);
    SA_LOAD(ra, 0, 512); SA_SCORE(rb, 5);
    } else if constexpr (NQ == 2) {
    SA_LOAD(ra, 0, 0);
    SA_LOAD(rb, 1, 0); SA_SCORE(ra, 0);
    SA_LOAD(ra, 2, 0); SA_SCORE(rb, 1);
    SA_LOAD(rb, 3, 0); SA_SCORE(ra, 2);
    SA_LOAD(ra, 4, 0); SA_SCORE(rb, 3);
    SA_LOAD(rb, 5, 0); SA_SCORE(ra, 4);
    SA_LOAD(ra, 6, 0); SA_SCORE(rb, 5);
    SA_LOAD(rb, 0, 512); SA_SCORE(ra, 6);
    } else {
#pragma unroll 1
    for (int b = 0; b < NB; ++b) {
        float4 kr[8];
#pragma unroll
        for (int i = 0; i < 8; ++i) { const int u = 4 * (b * 8 + i) + ks; const int idx = rho + d * u;
            const float* p = idx < wb ? cg + (size_t)idx * 1024 : kn + (size_t)(idx - wb) * 1024;
            kr[i] = u < U ? *(const float4*)p : make_float4(0.f, 0.f, 0.f, 0.f); }
#pragma unroll
        for (int i = 0; i < 8; ++i) { const int u = 4 * (b * 8 + i) + ks; float wsel = -INFINITY;
#pragma unroll
            for (int qi = 0; qi < NQ; ++qi) {
                float dp = qf[qi].x * kr[i].x + qf[qi].y * kr[i].y + qf[qi].z * kr[i].z + qf[qi].w * kr[i].w;
                dp = dpp_row16_sum(dp);
                const bool ok = (u >= qi) && (u <= qi + 128);
                const float v = ok ? dp - slope2d * (float)(128 + qi - u) : -INFINITY;
                wsel = (c == qi) ? v : wsel;
            }
            if (c < NQ && u < 136) sc[c * 136 + u] = wsel;
            __builtin_amdgcn_sched_barrier(0);
        }
    }
    }
    __builtin_amdgcn_wave_barrier();
#pragma unroll
    for (int qi = 0; qi < NQ; ++qi) {
        const float s0 = sc[qi * 136 + lane], s1 = sc[qi * 136 + 64 + lane], s2 = (128 + lane < U) ? sc[qi * 136 + 128 + lane] : -INFINITY;
        const float m = wave_max(fmaxf(fmaxf(s0, s1), s2));
        const float p0 = fexp2(s0 - m), p1 = fexp2(s1 - m), p2 = fexp2(s2 - m);
        const float l = wave_sum(p0 + p1 + p2), inv = frcp(l);
        pT[lane * NQ + qi] = p0 * inv; pT[(64 + lane) * NQ + qi] = p1 * inv; if (128 + lane < U) pT[(128 + lane) * NQ + qi] = p2 * inv;
        if (lane == 0) LSE[((size_t)G * M + MP + n * TS + rho + d * qi) * 8 + j] = m + flog2(l);
    }
    __builtin_amdgcn_wave_barrier();
    __builtin_amdgcn_sched_barrier(0);
    float4 o[NQ];
#pragma unroll
    for (int qi = 0; qi < NQ; ++qi) o[qi] = make_float4(0.f, 0.f, 0.f, 0.f);
    if constexpr (NQ == 1) {
    SA_LOAD(rb, 1, 512); SA_PV(ra, 0);
    SA_LOAD(ra, 2, 512); SA_PV(rb, 1);
    SA_LOAD(rb, 3, 512); SA_PV(ra, 2);
    SA_LOAD(ra, 4, 512); SA_PV(rb, 3);
    SA_LOAD(rb, 5, 512); SA_PV(ra, 4);
    SA_PV(rb, 5);
    } else if constexpr (NQ == 2) {
    SA_LOAD(ra, 1, 512); SA_PV(rb, 0);
    SA_LOAD(rb, 2, 512); SA_PV(ra, 1);
    SA_LOAD(ra, 3, 512); SA_PV(rb, 2);
    SA_LOAD(rb, 4, 512); SA_PV(ra, 3);
    SA_LOAD(ra, 5, 512); SA_PV(rb, 4);
    SA_LOAD(rb, 6, 512); SA_PV(ra, 5);
    SA_PV(rb, 6);
    } else {
#pragma unroll 1
    for (int b = 0; b < NB; ++b) {
        float4 vr[8];
#pragma unroll
        for (int i = 0; i < 8; ++i) { const int u = 4 * (b * 8 + i) + ks; const int idx = rho + d * u;
            const float* p = idx < wb ? cg + (size_t)idx * 1024 : kn + (size_t)(idx - wb) * 1024;
            vr[i] = u < U ? *(const float4*)(p + 512) : make_float4(0.f, 0.f, 0.f, 0.f); }
#pragma unroll
        for (int i = 0; i < 8; ++i) { const int u = 4 * (b * 8 + i) + ks;
#pragma unroll
            for (int qi = 0; qi < NQ; ++qi) { const float pq = u < U ? pT[u * NQ + qi] : 0.f;
                o[qi].x = fmaf(pq, vr[i].x, o[qi].x); o[qi].y = fmaf(pq, vr[i].y, o[qi].y); o[qi].z = fmaf(pq, vr[i].z, o[qi].z); o[qi].w = fmaf(pq, vr[i].w, o[qi].w); }
        }
    }
    }
#undef SA_LOAD
#undef SA_SCORE
#undef SA_PV
#pragma unroll
    for (int qi = 0; qi < NQ; ++qi) {
        float4 t = o[qi];
        t.x += __shfl_xor(t.x, 16); t.y += __shfl_xor(t.y, 16); t.z += __shfl_xor(t.z, 16); t.w += __shfl_xor(t.w, 16);
        t.x += __shfl_xor(t.x, 32); t.y += __shfl_xor(t.y, 32); t.z += __shfl_xor(t.z, 32); t.w += __shfl_xor(t.w, 32);
        if (ks == 0) { v2u w; w.x = pk2(t.x, t.y); w.y = pk2(t.z, t.w); *(v2u*)(OG + ((size_t)G * M + MP + n * TS + rho + d * qi) * 512 + j * 64 + 4 * c) = w; }
    }
    __builtin_amdgcn_wave_barrier();
}

constexpr int HG_P = 272;
constexpr int N_HG_ITEMS = NP * 4 * 64;
constexpr int HC_QI = 2048, HC_QD = HC_QI + 64 * HG_P, HC_QO = HC_QD + 64 * HG_P, HC_KD = HC_QO + 32 * HG_P, HC_KO = HC_KD + 64 * HG_P, HC_VI = HC_KO + 32 * HG_P,
              HC_SI = HC_VI + 64 * HG_P, HC_SS = HC_SI + 128 * HG_P, HC_END = HC_SS + 1024;
static_assert(HC_END <= RING_BYTES, "HGRN phase C LDS map");
constexpr int HA_KT = 2048, HA_VI = HA_KT + 128 * 144;
__device__ __forceinline__ void hg_scan(LAS unsigned char* lds, int f, int seg, const float (&lf)[16], float (&b)[16], float& B15, float& B31, float& B47, float& B63) {
    LAS float* TOT = (LAS float*)lds;
    float run = 0.f;
#pragma unroll
    for (int tt = 0; tt < 16; ++tt) { run += lf[tt]; b[tt] = run; }
    TOT[seg * 128 + f] = run;
    __syncthreads();
    const float t0 = TOT[f], t1 = TOT[128 + f], t2 = TOT[256 + f], t3 = TOT[384 + f];
    B15 = t0; B31 = t0 + t1; B47 = B31 + t2; B63 = B47 + t3;
    const float pre = seg == 0 ? 0.f : (seg == 1 ? B15 : (seg == 2 ? B31 : B47));
#pragma unroll
    for (int tt = 0; tt < 16; ++tt) b[tt] += pre;
}
__device__ __forceinline__ void hg_prep(LAS unsigned char* lds, const _Float16* LF, size_t row0, int col, int f, int seg, float (&lf)[16], float (&b)[16], float& B15, float& B31, float& B47, float& B63) {
#pragma unroll
    for (int tt = 0; tt < 16; ++tt) lf[tt] = (float)LF[(row0 + 16 * seg + tt) * 512 + col];
    hg_scan(lds, f, seg, lf, b, B15, B31, B47, B63);
}
__device__ __forceinline__ bf16x8 tr_pair(unsigned addr) { return tr_read2<0, 4 * HG_P>(addr); }
struct HaPre { float lf[16]; v4u vch[2]; };
__device__ __forceinline__ void hgrn_phaseA_prefetch(HaPre& P, int item, const _Float16* LF, const bf16* IB, int tid) {
    const int nh = item >> 6, c = item & 63, n = nh >> 2, h = nh & 3;
    const size_t row0 = (size_t)n * TP + c * 64;
    const int f = tid & 127, seg = tid >> 7, col = h * 128 + f;
#pragma unroll
    for (int tt = 0; tt < 16; ++tt) P.lf[tt] = (float)LF[(row0 + 16 * seg + tt) * 512 + col];
#pragma unroll
    for (int k = 0; k < 2; ++k) { const int ci = tid + 512 * k, sr = ci >> 4, ch = ci & 15; P.vch[k] = *(const v4u*)(IB + (row0 + sr) * 512 + h * 128 + ch * 8); }
}
__device__ __forceinline__ void hgrn_phaseA_item(LAS unsigned char* lds, int item, HaPre& P, bool has_next, int item_next, const _Float16* LF, const bf16* IB, float* DS, float* DEC, int tid, int wave, int lane) {
    const int f = tid & 127, seg = tid >> 7;
    __syncthreads();
    float lf[16], b[16], B15, B31, B47, B63;
#pragma unroll
    for (int tt = 0; tt < 16; ++tt) lf[tt] = P.lf[tt];
    v4u vch[2]; vch[0] = P.vch[0]; vch[1] = P.vch[1];
    hg_scan(lds, f, seg, lf, b, B15, B31, B47, B63);
    if (has_next) hgrn_phaseA_prefetch(P, item_next, LF, IB, tid);
    {
        float kk[16];
#pragma unroll
        for (int tt = 0; tt < 16; ++tt) kk[tt] = (1.0f - fexp2(lf[tt])) * fexp2(B63 - b[tt]);
        v4u w0, w1;
        w0.x = pk2(kk[0], kk[1]); w0.y = pk2(kk[2], kk[3]); w0.z = pk2(kk[4], kk[5]); w0.w = pk2(kk[6], kk[7]);
        w1.x = pk2(kk[8], kk[9]); w1.y = pk2(kk[10], kk[11]); w1.z = pk2(kk[12], kk[13]); w1.w = pk2(kk[14], kk[15]);
        *(LAS v4u*)(lds + HA_KT + f * 144 + seg * 32) = w0; *(LAS v4u*)(lds + HA_KT + f * 144 + seg * 32 + 16) = w1;
    }
#pragma unroll
    for (int k = 0; k < 2; ++k) { const int ci = tid + 512 * k, sr = ci >> 4, ch = ci & 15; *(LAS v4u*)(lds + HA_VI + sr * HG_P + ch * 16) = vch[k]; }
    if (seg == 0) DEC[(size_t)item * 128 + f] = fexp2(B63);
    __syncthreads();
    const int fm = wave >> 1, hh = lane >> 5, l31 = lane & 31;
    const unsigned vlane = (unsigned)(size_t)(lds + HA_VI) + (unsigned)(((lane & 15) >> 2) * HG_P + (16 * ((lane >> 4) & 1) + 4 * (lane & 3)) * 2 + 8 * hh * HG_P);
#pragma unroll
    for (int im2 = 0; im2 < 2; ++im2) {
        const int im = 2 * (wave & 1) + im2;
        f32x16 acc;
#pragma unroll
        for (int e = 0; e < 16; ++e) acc[e] = 0.f;
        const TrQuad vq = tr_read8<0, 4 * HG_P, 16 * HG_P, 20 * HG_P, 32 * HG_P, 36 * HG_P, 48 * HG_P, 52 * HG_P>(vlane + 64 * im);
#pragma unroll
        for (int ks = 0; ks < 4; ++ks) {
            const bf16x8 A = *(const LAS bf16x8*)(lds + HA_KT + (32 * fm + l31) * 144 + (16 * ks + 8 * hh) * 2);
            acc = __builtin_amdgcn_mfma_f32_32x32x16_bf16(A, ks == 0 ? vq.a : (ks == 1 ? vq.b : (ks == 2 ? vq.c : vq.d)), acc, 0, 0, 0);
        }
#pragma unroll
        for (int e4 = 0; e4 < 4; ++e4)
            { v2u w; w.x = pk2(acc[4 * e4 + 0], acc[4 * e4 + 1]); w.y = pk2(acc[4 * e4 + 2], acc[4 * e4 + 3]);
              *(v2u*)((bf16*)DS + ((size_t)item * 128 + 32 * im + l31) * 128 + 32 * fm + 8 * e4 + 4 * hh) = w; }
    }
}
struct HcPre { float lf[16]; unsigned short qraw[16]; v4u vch[2], sch[4]; };
__device__ __forceinline__ void hgrn_phaseC_prefetch(HcPre& P, int item, const _Float16* LF, const bf16* QB, const bf16* IB, const bf16* SB, int tid) {
    const int nh = item >> 6, c = item & 63, n = nh >> 2, h = nh & 3;
    const size_t row0 = (size_t)n * TP + c * 64;
    const int f = tid & 127, seg = tid >> 7, col = h * 128 + f;
#pragma unroll
    for (int tt = 0; tt < 16; ++tt) { P.lf[tt] = (float)LF[(row0 + 16 * seg + tt) * 512 + col]; P.qraw[tt] = QB[(row0 + 16 * seg + tt) * 512 + col]; }
#pragma unroll
    for (int k = 0; k < 2; ++k) { const int ci = tid + 512 * k, sr = ci >> 4, ch = ci & 15; P.vch[k] = *(const v4u*)(IB + (row0 + sr) * 512 + h * 128 + ch * 8); }
    if (c > 0) {
#pragma unroll
        for (int k = 0; k < 4; ++k) { const int ci = tid + 512 * k, fr = ci >> 4, ch = ci & 15; P.sch[k] = *(const v4u*)(SB + ((size_t)item * 128 + fr) * 128 + ch * 8); }
    }
}
__device__ __forceinline__ void hgrn_phaseC_item(LAS unsigned char* lds, int item, HcPre& P, bool has_next, int item_next, const _Float16* LF, const bf16* QB, const bf16* IB, const bf16* ZB, const bf16* SB,
                                                 const float* o_gain, bf16* OB, int tid, int wave, int lane) {
    const int nh = item >> 6, c = item & 63, n = nh >> 2, h = nh & 3;
    const size_t row0 = (size_t)n * TP + c * 64;
    const int f = tid & 127, seg = tid >> 7;
    __syncthreads();
    float b[16], B15, B31, B47, B63;
    hg_scan(lds, f, seg, P.lf, b, B15, B31, B47, B63);
    {
        const int blk = seg >> 1; const float mid = blk ? B47 : B15;
#pragma unroll
        for (int tt = 0; tt < 16; ++tt) {
            const int t = 16 * seg + tt;
            const float qv = bf2f(P.qraw[tt]), kf = 1.0f - fexp2(P.lf[tt]);
            *(LAS bf16*)(lds + HC_QI + t * HG_P + f * 2) = (bf16)f2bf(qv * fexp2(b[tt]));
            *(LAS bf16*)(lds + HC_QD + t * HG_P + f * 2) = (bf16)f2bf(qv * fexp2(b[tt] - mid));
            *(LAS bf16*)(lds + HC_KD + t * HG_P + f * 2) = (bf16)f2bf(kf * fexp2(mid - b[tt]));
            if (blk) *(LAS bf16*)(lds + HC_QO + (t - 32) * HG_P + f * 2) = (bf16)f2bf(qv * fexp2(b[tt] - B31));
            else     *(LAS bf16*)(lds + HC_KO + t * HG_P + f * 2) = (bf16)f2bf(kf * fexp2(B31 - b[tt]));
        }
    }
#pragma unroll
    for (int k = 0; k < 2; ++k) { const int ci = tid + 512 * k, sr = ci >> 4, ch = ci & 15; *(LAS v4u*)(lds + HC_VI + sr * HG_P + ch * 16) = P.vch[k]; }
    if (c > 0) {
#pragma unroll
        for (int k = 0; k < 4; ++k) { const int ci = tid + 512 * k, fr = ci >> 4, ch = ci & 15; *(LAS v4u*)(lds + HC_SI + fr * HG_P + ch * 16) = P.sch[k]; }
    }
    if (has_next) hgrn_phaseC_prefetch(P, item_next, LF, QB, IB, SB, tid);
    __syncthreads();
    const int tt2 = wave & 1, im = wave >> 1, hh = lane >> 5, l31 = lane & 31;
    const int keyi = (l31 & ~0xC) | ((l31 & 4) << 1) | ((l31 & 8) >> 1);
    v2u zq[4]; f32x4 gq[4];
#pragma unroll
    for (int e4 = 0; e4 < 4; ++e4) { const int i0 = 32 * im + 8 * e4 + 4 * hh; gq[e4] = *(const f32x4*)(o_gain + i0); zq[e4] = *(const v2u*)(ZB + (row0 + 32 * tt2 + l31) * 512 + h * 128 + i0); }
    f32x16 Xd, Xo;
#pragma unroll
    for (int e = 0; e < 16; ++e) { Xd[e] = 0.f; Xo[e] = 0.f; }
#pragma unroll
    for (int kf = 0; kf < 8; ++kf) {
        const bf16x8 A = *(const LAS bf16x8*)(lds + HC_KD + (32 * tt2 + keyi) * HG_P + (16 * kf + 8 * hh) * 2);
        const bf16x8 B = *(const LAS bf16x8*)(lds + HC_QD + (32 * tt2 + l31) * HG_P + (16 * kf + 8 * hh) * 2);
        Xd = __builtin_amdgcn_mfma_f32_32x32x16_bf16(A, B, Xd, 0, 0, 0);
    }
#pragma unroll
    for (int e = 0; e < 16; ++e) { const int sl = (e & 3) + 4 * ((e >> 2) & 1) + 16 * (e >> 3) + 8 * hh; Xd[e] = (sl <= l31) ? Xd[e] : 0.f; }
    if (tt2 == 1) {
#pragma unroll
        for (int kf = 0; kf < 8; ++kf) {
            const bf16x8 A = *(const LAS bf16x8*)(lds + HC_KO + keyi * HG_P + (16 * kf + 8 * hh) * 2);
            const bf16x8 B = *(const LAS bf16x8*)(lds + HC_QO + l31 * HG_P + (16 * kf + 8 * hh) * 2);
            Xo = __builtin_amdgcn_mfma_f32_32x32x16_bf16(A, B, Xo, 0, 0, 0);
        }
    }
    f32x16 acc;
#pragma unroll
    for (int e = 0; e < 16; ++e) acc[e] = 0.f;
    const unsigned lanep = (unsigned)(((lane & 15) >> 2) * HG_P + (16 * ((lane >> 4) & 1) + 4 * (lane & 3)) * 2 + 8 * hh * HG_P + 64 * im);
    const unsigned vlane = (unsigned)(size_t)(lds + HC_VI) + lanep;
    {
        const TrQuad vq = tr_read8<0, 4 * HG_P, 16 * HG_P, 20 * HG_P, 32 * HG_P, 36 * HG_P, 48 * HG_P, 52 * HG_P>(vlane);
        if (tt2 == 1) {
#pragma unroll
            for (int ks = 0; ks < 2; ++ks) {
                v4u pw; pw.x = pk2(Xo[8 * ks + 0], Xo[8 * ks + 1]); pw.y = pk2(Xo[8 * ks + 2], Xo[8 * ks + 3]); pw.z = pk2(Xo[8 * ks + 4], Xo[8 * ks + 5]); pw.w = pk2(Xo[8 * ks + 6], Xo[8 * ks + 7]);
                acc = __builtin_amdgcn_mfma_f32_32x32x16_bf16(ks ? vq.b : vq.a, __builtin_bit_cast(bf16x8, pw), acc, 0, 0, 0);
            }
        }
#pragma unroll
        for (int ks = 0; ks < 2; ++ks) {
            v4u pw; pw.x = pk2(Xd[8 * ks + 0], Xd[8 * ks + 1]); pw.y = pk2(Xd[8 * ks + 2], Xd[8 * ks + 3]); pw.z = pk2(Xd[8 * ks + 4], Xd[8 * ks + 5]); pw.w = pk2(Xd[8 * ks + 6], Xd[8 * ks + 7]);
            const bf16x8 A = tt2 ? (ks ? vq.d : vq.c) : (ks ? vq.b : vq.a);
            acc = __builtin_amdgcn_mfma_f32_32x32x16_bf16(A, __builtin_bit_cast(bf16x8, pw), acc, 0, 0, 0);
        }
    }
    if (c > 0) {
#pragma unroll
        for (int kf = 0; kf < 8; ++kf) {
            const bf16x8 A = *(const LAS bf16x8*)(lds + HC_SI + (32 * im + l31) * HG_P + (16 * kf + 8 * hh) * 2);
            const bf16x8 B = *(const LAS bf16x8*)(lds + HC_QI + (32 * tt2 + l31) * HG_P + (16 * kf + 8 * hh) * 2);
            acc = __builtin_amdgcn_mfma_f32_32x32x16_bf16(A, B, acc, 0, 0, 0);
        }
    }
    float ss = 0.f;
#pragma unroll
    for (int e = 0; e < 16; ++e) ss += acc[e] * acc[e];
    ss += __shfl_xor(ss, 32);
    LAS float* SS = (LAS float*)(lds + HC_SS);
    if (hh == 0) SS[im * 64 + 32 * tt2 + l31] = ss;
    __syncthreads();
    const int t = 32 * tt2 + l31;
    const float tot = (SS[t] + SS[64 + t]) + (SS[128 + t] + SS[192 + t]);
    const float rstd = frsq(tot * (1.0f / 128.f) + EPS);
#pragma unroll
    for (int e4 = 0; e4 < 4; ++e4) {
        const int i0 = 32 * im + 8 * e4 + 4 * hh;
        const f32x4 gn = gq[e4];
        const v2u z = zq[e4];
        v2u w; w.x = pk2(acc[4 * e4 + 0] * rstd * gn[0] * bflo(z.x), acc[4 * e4 + 1] * rstd * gn[1] * bfhi(z.x));
        w.y = pk2(acc[4 * e4 + 2] * rstd * gn[2] * bflo(z.y), acc[4 * e4 + 3] * rstd * gn[3] * bfhi(z.y));
        *(v2u*)(OB + (row0 + t) * 1024 + h * 128 + i0) = w;
    }
}
__device__ __forceinline__ void hgrn_sample_item(LAS float* wl, int item, const _Float16* LF, const bf16* QB, const bf16* IB, const float* state_in, float* OBR, float* out_state, int lane) {
    const int half = item & 1, nh = item >> 1, h = nh & 3, n = nh >> 2;
    const int cq = lane & 15, fq = lane >> 4;
    LAS float* FV = wl; LAS float* QV = wl + 1024;
    const size_t rowb = (size_t)MP + n * TS;
    {
        _Float16 lfr[2 * TS]; bf16 qbr[2 * TS];
#pragma unroll
        for (int t = 0; t < TS; ++t)
#pragma unroll
            for (int k = 0; k < 2; ++k) { const int f = lane + 64 * k; lfr[2 * t + k] = LF[(rowb + t) * 512 + h * 128 + f]; qbr[2 * t + k] = QB[(rowb + t) * 512 + h * 128 + f]; }
        __builtin_amdgcn_sched_barrier(0);
#pragma unroll
        for (int t = 0; t < TS; ++t)
#pragma unroll
            for (int k = 0; k < 2; ++k) { const int f = lane + 64 * k; FV[t * 128 + f] = fexp2((float)lfr[2 * t + k]); QV[t * 128 + f] = bf2f(qbr[2 * t + k]); }
    }
    f32x4 S[32];
    const float* s0 = state_in + ((size_t)nh * 128 + 32 * fq) * 128 + 64 * half + 4 * cq;
#pragma unroll
    for (int ff = 0; ff < 32; ++ff) S[ff] = *(const f32x4*)(s0 + (size_t)ff * 128);
    __builtin_amdgcn_wave_barrier();
    v2u vnext = *(const v2u*)(IB + rowb * 512 + h * 128 + 64 * half + 4 * cq);
#pragma unroll 1
    for (int t = 0; t < TS; ++t) {
        const v2u vw = vnext;
        if (t + 1 < TS) vnext = *(const v2u*)(IB + (rowb + t + 1) * 512 + h * 128 + 64 * half + 4 * cq);
        const f32x4 v = (f32x4){bflo(vw.x), bfhi(vw.x), bflo(vw.y), bfhi(vw.y)};
        f32x4 o = (f32x4){0.f, 0.f, 0.f, 0.f};
#pragma unroll
        for (int j = 0; j < 8; ++j) {
            const f32x4 F = *(const LAS f32x4*)(FV + t * 128 + 32 * fq + 4 * j), Q = *(const LAS f32x4*)(QV + t * 128 + 32 * fq + 4 * j);
#pragma unroll
            for (int e = 0; e < 4; ++e) { S[4 * j + e] = S[4 * j + e] * F[e] + v * (1.0f - F[e]); o = o + S[4 * j + e] * Q[e]; }
        }
#pragma unroll
        for (int e = 0; e < 4; ++e) { o[e] += __shfl_xor(o[e], 16); o[e] += __shfl_xor(o[e], 32); }
        if (fq == 0) *(f32x4*)(OBR + (rowb + t) * 512 + h * 128 + 64 * half + 4 * cq) = o;
    }
    float* so = out_state + ((size_t)nh * 128 + 32 * fq) * 128 + 64 * half + 4 * cq;
#pragma unroll
    for (int ff = 0; ff < 32; ++ff) *(f32x4*)(so + (size_t)ff * 128) = S[ff];
    __builtin_amdgcn_wave_barrier();
}


#define DPPF(x, ctrl) __builtin_bit_cast(float, __builtin_amdgcn_update_dpp(0, __builtin_bit_cast(int, (x)), (ctrl), 0xF, 0xF, true))
template <int NQ> __device__ __forceinline__ float row16_reduce_t(const float (&v)[4 * NQ], int c) {
    const bool b0 = c & 1, b1 = c & 2;
    float s[2 * NQ];
#pragma unroll
    for (int k = 0; k < 2 * NQ; ++k) { const float keep = b0 ? v[2 * k + 1] : v[2 * k], send = b0 ? v[2 * k] : v[2 * k + 1]; s[k] = keep + DPPF(send, 0xB1); }
    float t[NQ];
#pragma unroll
    for (int k = 0; k < NQ; ++k) { const float keep = b1 ? s[2 * k + 1] : s[2 * k], send = b1 ? s[2 * k] : s[2 * k + 1]; t[k] = keep + DPPF(send, 0x4E); }
#pragma unroll
    for (int k = 0; k < NQ; ++k) { t[k] += DPPF(t[k], 0x128); t[k] += DPPF(t[k], 0x124); }
    if (NQ == 1) return t[0];
    return (c & 4) ? t[NQ - 1] : t[0];
}

constexpr int S4_RING3 = 2560;
constexpr int S4_RING = 4608;
template <int G> __device__ __forceinline__ void attn_sample_item4(LAS unsigned char* wlb, int n, int jh, int rho, const bf16* QA, const float* cacheg, const float* kvs_out, bf16* OG, float* LSE, int lane) {
    constexpr int d = G == 1 ? 4 : 16, NQ = G == 1 ? 2 : 1, wb = G == 1 ? 512 : 2048, U = 128 + NQ;
    constexpr int UG = (U + 3) / 4, NG = 2 * UG;
    static_assert(G == 2, "whole-row form, three-group ring: group 2 (group 1 runs as attn_sample_item4h)"); static_assert(4 * NQ * 136 * 4 <= S4_RING3 && S4_RING3 + 12 * 1024 <= 16384, "wave LDS region");
    const int jl = lane >> 4, c = lane & 15, hd = G * 8 + 4 * jh + jl;
    const float* cbase = cacheg + ((size_t)n * wb + rho) * 1024 + (4 * jh + jl) * 64 + 4 * c;
    const float* nbase = kvs_out + ((size_t)n * TS + rho) * 1024 + (4 * jh + jl) * 64 + 4 * c;
    const float slope2d = exp2f(-8.0f * (float)(hd + 1) / 24.0f) * LOG2E * (float)d;
    float4 qf[NQ];
#pragma unroll
    for (int qi = 0; qi < NQ; ++qi) { const v2u w = *(const v2u*)(QA + (size_t)(MP + n * TS + rho + d * qi) * 1536 + hd * 64 + 4 * c);
        qf[qi] = make_float4(bflo(w.x), bfhi(w.x), bflo(w.y), bfhi(w.y)); }
    LAS float* sc = (LAS float*)wlb;
    LAS unsigned char* ring = wlb + S4_RING3;
    float4 o[NQ];
#pragma unroll
    for (int qi = 0; qi < NQ; ++qi) o[qi] = make_float4(0.f, 0.f, 0.f, 0.f);
#define S4_ISSUE(GI, SLOT) do { const int g_ = (GI); const int gg_ = g_ < UG ? g_ : g_ - UG; const unsigned vo_ = g_ < UG ? 0u : 2048u; \
        LAS unsigned char* slot_ = ring + (SLOT) * 4096; \
        if (gg_ < 32) { const char* b_ = (const char*)cbase + ((unsigned)gg_ * (unsigned)(4 * d * 4096) + vo_); \
            _Pragma("unroll") for (int r_ = 0; r_ < 4; ++r_) __builtin_amdgcn_global_load_lds((const unsigned*)(b_ + (unsigned)(r_ * d * 4096)), (LAS unsigned*)(slot_ + r_ * 1024), 16, 0, 2); } \
        else { _Pragma("unroll") for (int r_ = 0; r_ < 4; ++r_) { const int un_ = r_ < NQ ? r_ : NQ - 1; \
            __builtin_amdgcn_global_load_lds((const unsigned*)((const char*)nbase + ((unsigned)(un_ * d * 4096) + vo_)), (LAS unsigned*)(slot_ + r_ * 1024), 16, 0, 0); } } } while (0)
    asm volatile("s_waitcnt vmcnt(0)" ::: "memory");
    S4_ISSUE(0, 0); S4_ISSUE(1, 1); S4_ISSUE(2, 2);
    int cs = 0;
#pragma unroll 1
    for (int gi = 0; gi < NG; ++gi) {
        if (gi + 3 <= NG) asm volatile("s_waitcnt vmcnt(8)" ::: "memory"); else if (gi + 2 <= NG) asm volatile("s_waitcnt vmcnt(4)" ::: "memory"); else asm volatile("s_waitcnt vmcnt(0)" ::: "memory");
        f32x4 vv[4];
#pragma unroll
        for (int r = 0; r < 4; ++r) vv[r] = *(const LAS f32x4*)(ring + (cs * 4 + r) * 1024 + lane * 16);
        asm volatile("s_waitcnt lgkmcnt(0)" ::: "memory");
        if (gi + 3 < NG) S4_ISSUE(gi + 3, cs);
        cs = cs == 2 ? 0 : cs + 1;
        if (gi < UG) {
            float dv[4 * NQ];
#pragma unroll
            for (int r = 0; r < 4; ++r)
#pragma unroll
                for (int qi = 0; qi < NQ; ++qi) dv[r * NQ + qi] = qf[qi].x * vv[r][0] + qf[qi].y * vv[r][1] + qf[qi].z * vv[r][2] + qf[qi].w * vv[r][3];
            const float dsum = row16_reduce_t<NQ>(dv, c);
            {
                const int er = c / NQ, eq = c % NQ, u = 4 * gi + er;
                const bool ok = (u >= eq) && (u <= eq + 128);
                const float w = ok ? fmaf(slope2d, (float)(u - 128 - eq), dsum) : -INFINITY;
                if (c < 4 * NQ) sc[(jl * NQ + eq) * 136 + u] = w;
            }
            if (gi == UG - 1) {
                __builtin_amdgcn_wave_barrier();
#pragma unroll
                for (int hq = 0; hq < 4 * NQ; ++hq) {
                    const float s0 = sc[hq * 136 + lane], s1 = sc[hq * 136 + 64 + lane], s2 = (128 + lane < U) ? sc[hq * 136 + 128 + lane] : -INFINITY;
                    const float m = wave_max(fmaxf(fmaxf(s0, s1), s2));
                    const float p0 = fexp2(s0 - m), p1 = fexp2(s1 - m), p2 = fexp2(s2 - m);
                    const float l = wave_sum(p0 + p1 + p2), inv = frcp(l);
                    sc[hq * 136 + lane] = p0 * inv; sc[hq * 136 + 64 + lane] = p1 * inv; if (128 + lane < 136) sc[hq * 136 + 128 + lane] = (128 + lane < U) ? p2 * inv : 0.f;
                    if (lane == 0) LSE[((size_t)G * M + MP + n * TS + rho + d * (hq % NQ)) * 8 + 4 * jh + hq / NQ] = m + flog2(l);
                }
                __builtin_amdgcn_wave_barrier();
                asm volatile("s_waitcnt vmcnt(0)" ::: "memory");
            }
        } else {
#pragma unroll
            for (int r = 0; r < 4; ++r) {
                const int u = 4 * (gi - UG) + r;
#pragma unroll
                for (int qi = 0; qi < NQ; ++qi) { const float pq = sc[(jl * NQ + qi) * 136 + u];
                    o[qi].x = fmaf(pq, vv[r][0], o[qi].x); o[qi].y = fmaf(pq, vv[r][1], o[qi].y); o[qi].z = fmaf(pq, vv[r][2], o[qi].z); o[qi].w = fmaf(pq, vv[r][3], o[qi].w); }
            }
        }
    }
#undef S4_ISSUE
#pragma unroll
    for (int qi = 0; qi < NQ; ++qi) { v2u w; w.x = pk2(o[qi].x, o[qi].y); w.y = pk2(o[qi].z, o[qi].w);
        *(v2u*)(OG + ((size_t)G * M + MP + n * TS + rho + d * qi) * 512 + (4 * jh + jl) * 64 + 4 * c) = w; }
    __builtin_amdgcn_wave_barrier();
}

__device__ __forceinline__ void attn_sample_item4h(LAS unsigned char* wlb, int n, int jh, int rho, int hw, const bf16* QA, const float* cacheg, const float* kvs_out, bf16* OG, float* LSE, int lane) {
    constexpr int G = 1, d = 4, NQ = 2, wb = 512, U = 128 + NQ;
    constexpr int UG = (U + 7) / 8, NG = 2 * UG;
    static_assert(2 * NQ * 136 * 4 <= S4_RING3 && S4_RING3 + 12 * 1024 <= 16384 && 8 * UG <= 136, "wave LDS region");
    const int hh = lane >> 5, jl = (lane >> 4) & 1, c = lane & 15, hs = 4 * jh + 2 * hw + jl, hd = G * 8 + hs;
    const float* cbase = cacheg + ((size_t)n * wb + rho + d * hh) * 1024 + hs * 64 + 4 * c;
    const float* nbase = kvs_out + ((size_t)n * TS + rho) * 1024 + hs * 64 + 4 * c;
    const float* nb0 = nbase + (size_t)hh * d * 1024;
    const float* nb1 = nbase + (size_t)d * 1024;
    const float slope2d = exp2f(-8.0f * (float)(hd + 1) / 24.0f) * LOG2E * (float)d;
    float4 qf[NQ];
#pragma unroll
    for (int qi = 0; qi < NQ; ++qi) { const v2u w = *(const v2u*)(QA + (size_t)(MP + n * TS + rho + d * qi) * 1536 + hd * 64 + 4 * c);
        qf[qi] = make_float4(bflo(w.x), bfhi(w.x), bflo(w.y), bfhi(w.y)); }
    LAS float* sc = (LAS float*)wlb;
    LAS unsigned char* ring = wlb + S4_RING3;
    float4 o[NQ];
#pragma unroll
    for (int qi = 0; qi < NQ; ++qi) o[qi] = make_float4(0.f, 0.f, 0.f, 0.f);
#define S4H_ISSUE(GI, SLOT) do { const int g_ = (GI); const int gg_ = g_ < UG ? g_ : g_ - UG; const unsigned vo_ = g_ < UG ? 0u : 2048u; \
        LAS unsigned char* slot_ = ring + (SLOT) * 4096; \
        if (gg_ < 16) { const char* b_ = (const char*)cbase + ((unsigned)gg_ * (unsigned)(8 * d * 4096) + vo_); \
            _Pragma("unroll") for (int r_ = 0; r_ < 4; ++r_) __builtin_amdgcn_global_load_lds((const unsigned*)(b_ + (unsigned)(r_ * 2 * d * 4096)), (LAS unsigned*)(slot_ + r_ * 1024), 16, 0, 2); } \
        else { _Pragma("unroll") for (int r_ = 0; r_ < 4; ++r_) \
            __builtin_amdgcn_global_load_lds((const unsigned*)((const char*)(r_ == 0 ? nb0 : nb1) + vo_), (LAS unsigned*)(slot_ + r_ * 1024), 16, 0, 0); } } while (0)
    asm volatile("s_waitcnt vmcnt(0)" ::: "memory");
    S4H_ISSUE(0, 0); S4H_ISSUE(1, 1); S4H_ISSUE(2, 2);
    int cs = 0;
#pragma unroll 1
    for (int gi = 0; gi < NG; ++gi) {
        if (gi + 3 <= NG) asm volatile("s_waitcnt vmcnt(8)" ::: "memory"); else if (gi + 2 <= NG) asm volatile("s_waitcnt vmcnt(4)" ::: "memory"); else asm volatile("s_waitcnt vmcnt(0)" ::: "memory");
        f32x4 vv[4];
#pragma unroll
        for (int r = 0; r < 4; ++r) vv[r] = *(const LAS f32x4*)(ring + (cs * 4 + r) * 1024 + lane * 16);
        asm volatile("s_waitcnt lgkmcnt(0)" ::: "memory");
        if (gi + 3 < NG) S4H_ISSUE(gi + 3, cs);
        cs = cs == 2 ? 0 : cs + 1;
        if (gi < UG) {
            float dv[4 * NQ];
#pragma unroll
            for (int r = 0; r < 4; ++r)
#pragma unroll
                for (int qi = 0; qi < NQ; ++qi) dv[r * NQ + qi] = qf[qi].x * vv[r][0] + qf[qi].y * vv[r][1] + qf[qi].z * vv[r][2] + qf[qi].w * vv[r][3];
            const float dsum = row16_reduce_t<NQ>(dv, c);
            {
                const int er = c / NQ, eq = c % NQ, u = 8 * gi + 2 * er + hh;
                const bool ok = (u >= eq) && (u <= eq + 128);
                const float w = ok ? fmaf(slope2d, (float)(u - 128 - eq), dsum) : -INFINITY;
                if (c < 4 * NQ) sc[(jl * NQ + eq) * 136 + u] = w;
            }
            if (gi == UG - 1) {
                __builtin_amdgcn_wave_barrier();
#pragma unroll
                for (int hq = 0; hq < 2 * NQ; ++hq) {
                    const float s0 = sc[hq * 136 + lane], s1 = sc[hq * 136 + 64 + lane], s2 = (128 + lane < U) ? sc[hq * 136 + 128 + lane] : -INFINITY;
                    const float m = wave_max(fmaxf(fmaxf(s0, s1), s2));
                    const float p0 = fexp2(s0 - m), p1 = fexp2(s1 - m), p2 = fexp2(s2 - m);
                    const float l = wave_sum(p0 + p1 + p2), inv = frcp(l);
                    sc[hq * 136 + lane] = p0 * inv; sc[hq * 136 + 64 + lane] = p1 * inv; if (128 + lane < 136) sc[hq * 136 + 128 + lane] = (128 + lane < U) ? p2 * inv : 0.f;
                    if (lane == 0) LSE[((size_t)G * M + MP + n * TS + rho + d * (hq % NQ)) * 8 + 4 * jh + 2 * hw + hq / NQ] = m + flog2(l);
                }
                __builtin_amdgcn_wave_barrier();
                asm volatile("s_waitcnt vmcnt(0)" ::: "memory");
            }
        } else {
#pragma unroll
            for (int r = 0; r < 4; ++r) {
                const int u = 8 * (gi - UG) + 2 * r + hh;
#pragma unroll
                for (int qi = 0; qi < NQ; ++qi) { const float pq = sc[(jl * NQ + qi) * 136 + u];
                    o[qi].x = fmaf(pq, vv[r][0], o[qi].x); o[qi].y = fmaf(pq, vv[r][1], o[qi].y); o[qi].z = fmaf(pq, vv[r][2], o[qi].z); o[qi].w = fmaf(pq, vv[r][3], o[qi].w); }
            }
        }
    }
#undef S4H_ISSUE
#pragma unroll
    for (int qi = 0; qi < NQ; ++qi) {
        o[qi].x += __shfl_xor(o[qi].x, 32); o[qi].y += __shfl_xor(o[qi].y, 32); o[qi].z += __shfl_xor(o[qi].z, 32); o[qi].w += __shfl_xor(o[qi].w, 32);
        v2u w; w.x = pk2(o[qi].x, o[qi].y); w.y = pk2(o[qi].z, o[qi].w);
        if (hh == 0) *(v2u*)(OG + ((size_t)G * M + MP + n * TS + rho + d * qi) * 512 + hs * 64 + 4 * c) = w; }
    __builtin_amdgcn_wave_barrier();
}

__device__ __forceinline__ void combine_row(int r, int lane, bool act, const bf16* OG, const float* LSE, const bf16* ZA, bf16* OA) {
    if (!act) return;
    const int j = lane >> 3;
    float ls[3], mxl = -INFINITY;
#pragma unroll
    for (int g = 0; g < 3; ++g) { ls[g] = LSE[((size_t)g * M + r) * 8 + j]; mxl = fmaxf(mxl, ls[g]); }
    float wsum = 0.f, acc8[8];
#pragma unroll
    for (int e = 0; e < 8; ++e) acc8[e] = 0.f;
#pragma unroll
    for (int g = 0; g < 3; ++g) { const float wg = fexp2(ls[g] - mxl); wsum += wg;
        const v4u w = *(const v4u*)(OG + ((size_t)g * M + r) * 512 + lane * 8);
        acc8[0] += wg * bflo(w.x); acc8[1] += wg * bfhi(w.x); acc8[2] += wg * bflo(w.y); acc8[3] += wg * bfhi(w.y);
        acc8[4] += wg * bflo(w.z); acc8[5] += wg * bfhi(w.z); acc8[6] += wg * bflo(w.w); acc8[7] += wg * bfhi(w.w); }
    const float inv = frcp(wsum);
    const v4u z = *(const v4u*)(ZA + (size_t)r * 512 + lane * 8);
    v4u o; o.x = pk2(acc8[0] * inv * bflo(z.x), acc8[1] * inv * bfhi(z.x)); o.y = pk2(acc8[2] * inv * bflo(z.y), acc8[3] * inv * bfhi(z.y));
    o.z = pk2(acc8[4] * inv * bflo(z.z), acc8[5] * inv * bfhi(z.z)); o.w = pk2(acc8[6] * inv * bflo(z.w), acc8[7] * inv * bfhi(z.w));
    *(v4u*)(OA + (size_t)r * 1024 + lane * 8) = o;
}
__device__ __forceinline__ void obnorm_item(int r, int h, int lane, const float* OBR, const bf16* ZB, const float* o_gain, bf16* OB) {
    const float* ob = OBR + (size_t)r * 512 + h * 128; const bf16* zb = ZB + (size_t)r * 512 + h * 128;
    const float v0 = ob[lane], v1 = ob[64 + lane];
    const float rstd = frsq(wave_sum(v0 * v0 + v1 * v1) * (1.0f / 128.f) + EPS);
    OB[(size_t)r * 1024 + h * 128 + lane] = (bf16)f2bf(v0 * rstd * o_gain[lane] * bf2f(zb[lane]));
    OB[(size_t)r * 1024 + h * 128 + 64 + lane] = (bf16)f2bf(v1 * rstd * o_gain[64 + lane] * bf2f(zb[64 + lane]));
}
__device__ __forceinline__ void obnorm_item2(int r, int h0, int lane, const float* OBR, const bf16* ZB, const float* o_gain, bf16* OB) {
    const float* ob = OBR + (size_t)r * 512 + h0 * 128; const bf16* zb = ZB + (size_t)r * 512 + h0 * 128;
    float v[4]; bf16 z[4];
#pragma unroll
    for (int k = 0; k < 4; ++k) { v[k] = ob[64 * k + lane]; z[k] = zb[64 * k + lane]; }
    const float g0 = o_gain[lane], g1 = o_gain[64 + lane];
    const float ra = frsq(wave_sum(v[0] * v[0] + v[1] * v[1]) * (1.0f / 128.f) + EPS), rb = frsq(wave_sum(v[2] * v[2] + v[3] * v[3]) * (1.0f / 128.f) + EPS);
    bf16* op = OB + (size_t)r * 1024 + h0 * 128;
    op[lane] = (bf16)f2bf(v[0] * ra * g0 * bf2f(z[0])); op[64 + lane] = (bf16)f2bf(v[1] * ra * g1 * bf2f(z[1]));
    op[128 + lane] = (bf16)f2bf(v[2] * rb * g0 * bf2f(z[2])); op[192 + lane] = (bf16)f2bf(v[3] * rb * g1 * bf2f(z[3]));
}
struct OneUnit {
    int pm, pn;
    __device__ __forceinline__ bool next(int i, pg8::Unit& u) const { if (i > 0) return false; u.pm = pm; u.pn = pn; return true; }
    __device__ __forceinline__ void a_ready(const pg8::Unit&) const {}
    __device__ __forceinline__ void done(const pg8::Unit&) const {}
};
constexpr int N_SGEMM_WG = (MS / 256) * (D / 256);

template <bool SC1 = false> __device__ __forceinline__ void h_rows(int r0, int stride, int rend, int lane, const float* x_p, const float* x_s, const float* norm_gain, const float* ADA, bf16* H) {
    float4 nx[4];
    if (r0 < rend) { const float* xr = r0 < MP ? x_p + (size_t)r0 * D : x_s + (size_t)(r0 - MP) * D;
#pragma unroll
        for (int j = 0; j < 4; ++j) nx[j] = *(const float4*)(xr + 512 * (j >> 1) + 8 * lane + 4 * (j & 1)); }
    for (int r = r0; r < rend; r += stride) {
        const int sq = seq_of_row(r);
        float4 v[4]; float ss = 0.f;
#pragma unroll
        for (int j = 0; j < 4; ++j) v[j] = nx[j];
        const int rn = r + stride;
        if (rn < rend) { const float* xr = rn < MP ? x_p + (size_t)rn * D : x_s + (size_t)(rn - MP) * D;
#pragma unroll
            for (int j = 0; j < 4; ++j) nx[j] = *(const float4*)(xr + 512 * (j >> 1) + 8 * lane + 4 * (j & 1)); }
        float4 gg[4], sh[4], sc[4];
#pragma unroll
        for (int j = 0; j < 4; ++j) { const int c = 512 * (j >> 1) + 8 * lane + 4 * (j & 1); gg[j] = *(const float4*)(norm_gain + c);
            if constexpr (!SC1) { sh[j] = *(const float4*)(ADA + (size_t)sq * 3072 + c); sc[j] = *(const float4*)(ADA + (size_t)sq * 3072 + 1024 + c); } }
        if constexpr (SC1) {
            const float* ab = ADA + (size_t)sq * 3072 + 8 * lane;
            f32x4 t0, t1, t2, t3, t4, t5, t6, t7;
            asm volatile("global_load_dwordx4 %0, %8, off sc1\n\tglobal_load_dwordx4 %1, %8, off offset:16 sc1\n\tglobal_load_dwordx4 %2, %8, off offset:2048 sc1\n\tglobal_load_dwordx4 %3, %8, off offset:2064 sc1\n\t"
                         "global_load_dwordx4 %4, %9, off sc1\n\tglobal_load_dwordx4 %5, %9, off offset:16 sc1\n\tglobal_load_dwordx4 %6, %9, off offset:2048 sc1\n\tglobal_load_dwordx4 %7, %9, off offset:2064 sc1\n\ts_waitcnt vmcnt(0)"
                         : "=&v"(t0), "=&v"(t1), "=&v"(t2), "=&v"(t3), "=&v"(t4), "=&v"(t5), "=&v"(t6), "=&v"(t7) : "v"(ab), "v"(ab + 1024) : "memory");
            sh[0] = make_float4(t0[0], t0[1], t0[2], t0[3]); sh[1] = make_float4(t1[0], t1[1], t1[2], t1[3]); sh[2] = make_float4(t2[0], t2[1], t2[2], t2[3]); sh[3] = make_float4(t3[0], t3[1], t3[2], t3[3]);
            sc[0] = make_float4(t4[0], t4[1], t4[2], t4[3]); sc[1] = make_float4(t5[0], t5[1], t5[2], t5[3]); sc[2] = make_float4(t6[0], t6[1], t6[2], t6[3]); sc[3] = make_float4(t7[0], t7[1], t7[2], t7[3]);
        }
#pragma unroll
        for (int j = 0; j < 4; ++j) ss += v[j].x * v[j].x + v[j].y * v[j].y + v[j].z * v[j].z + v[j].w * v[j].w;
        const float rstd = frsq(wave_sum(ss) * (1.0f / D) + EPS);
#pragma unroll
        for (int jp = 0; jp < 2; ++jp) {
            unsigned w[4];
#pragma unroll
            for (int k = 0; k < 2; ++k) { const int j = 2 * jp + k;
                const float ox = v[j].x * rstd * gg[j].x * (1.f + sc[j].x) + sh[j].x, oy = v[j].y * rstd * gg[j].y * (1.f + sc[j].y) + sh[j].y;
                const float oz = v[j].z * rstd * gg[j].z * (1.f + sc[j].z) + sh[j].z, ow = v[j].w * rstd * gg[j].w * (1.f + sc[j].w) + sh[j].w;
                w[2 * k] = pk2(ox, oy); w[2 * k + 1] = pk2(oz, ow); }
            *(v4u*)(H + (size_t)r * D + 512 * jp + 8 * lane) = (v4u){w[0], w[1], w[2], w[3]};
        }
    }
}
struct RangeOrder {
    pg8::StaticOrder P; int lo, hi;
    __device__ __forceinline__ bool next(int i, pg8::Unit& u) const { return lo + i < hi && P.next(lo + i, u); }
    __device__ __forceinline__ void a_ready(const pg8::Unit&) const {}
    __device__ __forceinline__ void done(const pg8::Unit&) const {}
};
constexpr int N_SIN_WG = (MS / 256) * (NIN / 256);

__device__ __forceinline__ void p0_transpose_pair(const float* W, int K, int N, bf16* WT, LAS float* scr, int itemA, int itemB, int lane) {
    const int nblk = N / 32;
    float wa[32], wb2[32];
    { const int kb = itemA / nblk, nb = itemA % nblk, k0 = 64 * kb, n0 = 32 * nb;
#pragma unroll
      for (int i = 0; i < 32; ++i) wa[i] = W[(size_t)(k0 + 2 * i + (lane >> 5)) * N + n0 + (lane & 31)]; }
    { const int kb = itemB / nblk, nb = itemB % nblk, k0 = 64 * kb, n0 = 32 * nb;
#pragma unroll
      for (int i = 0; i < 32; ++i) wb2[i] = W[(size_t)(k0 + 2 * i + (lane >> 5)) * N + n0 + (lane & 31)]; }
    const int c = lane & 7;
#pragma unroll
    for (int half = 0; half < 2; ++half) {
        const int item = half ? itemB : itemA; const int kb = item / nblk, nb = item % nblk, k0 = 64 * kb, n0 = 32 * nb;
#pragma unroll
        for (int i = 0; i < 32; ++i) scr[(2 * i + (lane >> 5)) * 33 + (lane & 31)] = half ? wb2[i] : wa[i];
        asm volatile("s_waitcnt lgkmcnt(0)" ::: "memory");
        const int pr0 = phys_row(n0);
#pragma unroll
        for (int j = 0; j < 4; ++j) { const int n = (lane >> 3) + 8 * j; const LAS float* sp = scr + (8 * c) * 33 + n;
            v4u o; o.x = pk2(sp[0 * 33], sp[1 * 33]); o.y = pk2(sp[2 * 33], sp[3 * 33]); o.z = pk2(sp[4 * 33], sp[5 * 33]); o.w = pk2(sp[6 * 33], sp[7 * 33]);
            *(v4u*)(WT + (size_t)(pr0 + n) * K + k0 + 8 * c) = o; }
        asm volatile("s_waitcnt lgkmcnt(0)" ::: "memory");
    }
}

#ifndef MK_ONE_LAUNCH
#define MK_ONE_LAUNCH 1
#endif
constexpr int NPHASE = 9;

struct Args { const float* in[19]; float* out; unsigned char* ws; int ph_lo, ph_hi; };

__global__ void __launch_bounds__(NTHR, 2) fwd(Args a) {
    extern __shared__ __attribute__((aligned(16))) unsigned char lds_raw[];
    float* lds = (float*)lds_raw;
    LAS unsigned char* ldsb = (LAS unsigned char*)lds_raw;
    volatile LAS unsigned* MISC = (volatile LAS unsigned*)(ldsb + MISC_OFF);
    const int tid = threadIdx.x, lane = tid & 63, wave = __builtin_amdgcn_readfirstlane(tid >> 6);
    const int gw = blockIdx.x * NWAVES + wave, NGW = gridDim.x * NWAVES;
    const float* x_p = a.in[0]; const float* x_s = a.in[1];
    const float* cache[3] = {a.in[2], a.in[3], a.in[4]};
    const float* state_in = a.in[5]; const float* c_p = a.in[6]; const float* c_s = a.in[7];
    const float* norm_gain = a.in[8]; const float* w_ada = a.in[9]; const float* b_ada = a.in[10]; const float* w_in = a.in[11];
    const float* q_gain = a.in[12]; const float* k_gain = a.in[13]; const float* lb_logits = a.in[14]; const float* o_gain = a.in[15];
    const float* w_ba = a.in[16]; const float* w_bb = a.in[17]; const float* w_out = a.in[18];
    float* out = a.out;
    unsigned* ctl = (unsigned*)(a.ws + WS_CTL);
    float* ADA = (float*)(a.ws + WS_ADA); float* LB = (float*)(a.ws + WS_LB);
    bf16* W1T = (bf16*)(a.ws + WS_W1T); bf16* WAT = (bf16*)(a.ws + WS_WAT); bf16* WOT = (bf16*)(a.ws + WS_WOT);
    bf16* H = (bf16*)(a.ws + WS_H);
    bf16* QA = (bf16*)(a.ws + WS_QA); bf16* KA = (bf16*)(a.ws + WS_KA); bf16* VA = (bf16*)(a.ws + WS_VA); bf16* ZA = (bf16*)(a.ws + WS_ZA);
    bf16* QB = (bf16*)(a.ws + WS_QB); bf16* IB = (bf16*)(a.ws + WS_IB); bf16* ZB = (bf16*)(a.ws + WS_ZB); _Float16* LF = (_Float16*)(a.ws + WS_LF);
    bf16* GA = (bf16*)(a.ws + WS_GA); bf16* GB = (bf16*)(a.ws + WS_GB);
    bf16* OA = (bf16*)(a.ws + WS_OA); bf16* OB = OA + 512; float* OBR = (float*)(a.ws + WS_OBR);
    bf16* MG = (bf16*)(a.ws + WS_MG);
    bf16* OG = (bf16*)(a.ws + WS_OG); float* LSE = (float*)(a.ws + WS_LSE);
    float* DS = (float*)(a.ws + WS_DS); float* DEC = (float*)(a.ws + WS_DEC); bf16* SB = (bf16*)(a.ws + WS_SB);
    const int lo = a.ph_lo, hi = a.ph_hi;
#define IN(k) (lo <= (k) && (k) < hi)
#define BOTH(k) (IN(k) && IN((k) + 1))

    for (int u = tid; u < (LDS_BYTES - RING_BYTES) / 4; u += NTHR) ((LAS unsigned*)(ldsb + RING_BYTES))[u] = 0u;
    __syncthreads();
    XcdBarrier bar; bar.bar = ctl + CW_BAR; bar.x = 0; bar.st = nullptr;
    if (MK_ONE_LAUNCH) bar = xcd_barrier_post(ctl + CW_BAR, MISC + 8);
#define GRID_BAR() do { if (MK_ONE_LAUNCH) xcd_barrier(bar); } while (0)

    if (IN(0)) {
        for (int it = wave * gridDim.x + blockIdx.x; it < 9 * 96; it += NGW) {
            const int cg = it / 9, st = it % 9;
            const int ar = lane & 15, ak = lane >> 4;
            int sq = 16 * st + ar; sq = sq < NSEQ ? sq : NSEQ - 1;
            const float* crow = (sq < NP ? c_p + (size_t)sq * D : c_s + (size_t)(sq - NP) * D) + 4 * ak;
            const float* wcol = w_ada + (size_t)(4 * ak) * 3072 + 32 * cg + 2 * ar;
            f32x4 acc[2];
#pragma unroll
            for (int c = 0; c < 2; ++c) acc[c] = (f32x4){0.f, 0.f, 0.f, 0.f};
            f32x4 av[8]; f32x2 bv[8][4];
#pragma unroll
            for (int s = 0; s < 7; ++s) { av[s] = *(const f32x4*)(crow + 16 * s);
#pragma unroll
                for (int s4 = 0; s4 < 4; ++s4) bv[s][s4] = *(const f32x2*)(wcol + (size_t)(16 * s + s4) * 3072);
                __builtin_amdgcn_sched_barrier(0); }
#pragma unroll 1
            for (int k0 = 0; k0 < D; k0 += 128) {
#pragma unroll
                for (int s = 0; s < 8; ++s) {
                    const int kn = k0 + 16 * s + 112;
                    const int kc = kn < D ? kn : D - 16;
                    av[(s + 7) & 7] = *(const f32x4*)(crow + kc);
#pragma unroll
                    for (int s4 = 0; s4 < 4; ++s4) bv[(s + 7) & 7][s4] = *(const f32x2*)(wcol + (size_t)(kc + s4) * 3072);
#pragma unroll
                    for (int s4 = 0; s4 < 4; ++s4) { const float a1 = siluf_(av[s][s4]);
#pragma unroll
                        for (int c = 0; c < 2; ++c) acc[c] = __builtin_amdgcn_mfma_f32_16x16x4f32(a1, bv[s][s4][c], acc[c], 0, 0, 0); }
                    __builtin_amdgcn_sched_barrier(0);
                }
            }
            const int col = 32 * cg + 2 * ar; const f32x2 bias = *(const f32x2*)(b_ada + col);
#pragma unroll
            for (int e = 0; e < 4; ++e) { const int row = 16 * st + 4 * ak + e;
                if (row < NSEQ) { const f32x2 v = (f32x2){acc[0][e] + bias[0], acc[1][e] + bias[1]}; float* dp = ADA + (size_t)row * 3072 + col;
                    asm volatile("global_store_dwordx2 %0, %1, off sc0 sc1" :: "v"(dp), "v"(v) : "memory"); } }
            asm volatile("s_waitcnt vmcnt(0)" ::: "memory");
            if (lane == 0) (void)xb_add(&ctl[CW_ADA + 64 * st], 1u);
        }
        if (blockIdx.x == 0) {
            const float l0 = lb_logits[tid], l1 = lb_logits[512 + tid];
            const float mx = fmaxf(l0, l1); const float e0 = expf(l0 - mx), e1 = expf(l1 - mx);
            LB[tid] = e0 / (e0 + e1);
        }
        LAS float* scr = (LAS float*)(ldsb + wave * 16384);
        constexpr int I_1 = (D / 64) * (NIN / 32), I_A = (512 / 64) * (D / 32), I_O = (D / 64) * (D / 32);
        const int G0 = (int)gridDim.x, nada = 9 * 96, afull = nada / G0, arem = nada % G0;
        const bool simple = afull >= 7;
        const bool had_ada = wave < afull || (wave == afull && (int)blockIdx.x < arem);
        const int trank = simple ? gw : ((int)blockIdx.x < arem ? (int)blockIdx.x * (7 - afull) + (wave - afull - 1) : arem * (7 - afull) + ((int)blockIdx.x - arem) * (8 - afull) + (wave - afull));
        const int tn = simple ? NGW : arem * (7 - afull) + (G0 - arem) * (8 - afull);
        if (simple || !had_ada) {
            for (int it = trank; it < I_1; it += 2 * tn) {
                const int itb = it + tn;
                if (itb < I_1) p0_transpose_pair(w_in, D, NIN, W1T, scr, it, itb, lane); else p0_transpose_item(w_in, D, NIN, W1T, scr, it, lane);
            }
            for (int it = trank; it < 2 * I_A + I_O; it += tn) {
                int r = it;
                if (r < I_A) { p0_transpose_item(w_ba, 512, D, WAT, scr, r, lane, 1024); continue; } r -= I_A;
                if (r < I_A) { p0_transpose_item(w_bb, 512, D, WAT + 512, scr, r, lane, 1024); continue; } r -= I_A;
                p0_transpose_item(w_out, D, D, WOT, scr, r, lane);
            }
        }
        if (BOTH(0)) {
            if ((int)blockIdx.x < NS) {
                if (tid == 0) { const int st = (NP + (int)blockIdx.x) >> 4; XB_SPIN(xb_ld(&ctl[CW_ADA + 64 * st]) < 96u, bar.bar); }
                __syncthreads();
                h_rows<true>(MP + gw, NGW, M, lane, x_p, x_s, norm_gain, ADA, H);
            }
            GRID_BAR();
        }
    }
    if (IN(1) && !IN(0)) {
        h_rows(MP + gw, NGW, M, lane, x_p, x_s, norm_gain, ADA, H);
        if (BOTH(1)) GRID_BAR();
    }
    if (IN(2)) {
        const int b = (int)blockIdx.x, G = (int)gridDim.x;
        if (b < N_SIN_WG && G > N_SIN_WG) {
            pg8::Gemm g{H, W1T, M, NIN, D}; const OneUnit S{MP / 256 + (b & 3), b >> 2};
            EpiIn E{a.ws, QA, KA, VA, LF, out, q_gain, k_gain, LB};
            pg8::gemm_phase<EpiIn, OneUnit, true, true>(ldsb, g, S, E);
        } else {
            const int nb = G > N_SIN_WG ? G - N_SIN_WG : G, bi = G > N_SIN_WG ? b - N_SIN_WG : b;
            h_rows(bi * NWAVES + wave, nb * NWAVES, MP, lane, x_p, x_s, norm_gain, ADA, H);
        }
        if (BOTH(2)) GRID_BAR();
    }
    if (IN(3)) {
        pg8::Gemm g{H, W1T, MP, NIN, D};
        EpiIn E{a.ws, QA, KA, VA, LF, out, q_gain, k_gain, LB};
        const int cut = ((int)blockIdx.x >> 3) % 9;
        { RangeOrder S; S.P.init(MP, NIN, gridDim.x, (int)blockIdx.x); S.lo = 0; S.hi = cut;
          pg8::gemm_phase<EpiIn, RangeOrder, true, true>(ldsb, g, S, E); }
        __syncthreads();
        {
            LAS float* wl = (LAS float*)(ldsb + wave * 16384); LAS unsigned char* wlb = ldsb + wave * 16384;
            const int task = blockIdx.x;
            if (task < 2 * NS) {
                const int n = task >> 1, jh = task & 1;
                attn_sample_item4<2>(wlb, n, jh, wave, QA, cache[2], out + O_KVS2, OG, LSE, lane);
                attn_sample_item4h(wlb, n, jh, wave & 3, wave >> 2, QA, cache[1], out + O_KVS1, OG, LSE, lane);
                if (wave < 4) attn_sample_item<0>(wl, n * 8 + 4 * jh + wave, QA, cache[0], out + O_KVS0, OG, LSE, lane);
                else hgrn_sample_item(wl, ((n * 4 + 2 * jh + ((wave - 4) >> 1)) << 1) | ((wave - 4) & 1), LF, QB, IB, state_in, OBR, out + O_HS, lane);
                __syncthreads();
                const int r = MP + n * TS + wave;
                combine_row(r, lane, (lane >> 5) == jh, OG, LSE, ZA, OA);
                obnorm_item2(r, 2 * jh, lane, OBR, ZB, o_gain, OB);
                __syncthreads();
            }
        }
        __syncthreads();
        { RangeOrder S; S.P.init(MP, NIN, gridDim.x, (int)blockIdx.x); S.lo = cut; S.hi = 1 << 20;
          pg8::gemm_phase<EpiIn, RangeOrder, true, true>(ldsb, g, S, E); }
        if (BOTH(3)) GRID_BAR();
    }
    if (IN(4)) {
        __syncthreads();
        const int urounds = (int)gridDim.x == 256 ? 4 : (N_ATT_UNITS + (int)gridDim.x - 1) / (int)gridDim.x;
        for (int k = 0; k < urounds; ++k) { const int u = (int)blockIdx.x + k * (int)gridDim.x; if (u < N_ATT_UNITS) attn_prompt_unit(ldsb, u, QA, KA, VA, OG, LSE, tid, wave, lane); }
        { HaPre P; if ((int)blockIdx.x < N_HG_ITEMS) hgrn_phaseA_prefetch(P, blockIdx.x, LF, IB, tid);
          for (int it = blockIdx.x; it < N_HG_ITEMS; it += gridDim.x) { const int itn = it + gridDim.x; hgrn_phaseA_item(ldsb, it, P, itn < N_HG_ITEMS, itn, LF, IB, DS, DEC, tid, wave, lane); } }
        if (BOTH(4) && MK_ONE_LAUNCH) xcd_barrier_arrive(bar);
    }
    if (IN(5)) {
        const bool sg = (int)blockIdx.x < N_SGEMM_WG && (int)gridDim.x > N_SGEMM_WG;
        if (sg) {
            const OneUnit S{MP / 256 + ((int)blockIdx.x >> 2), (int)blockIdx.x & 3};
            pg8::Gemm g{OA, WAT, M, D, D}; EpiG2 E{GA, GB, MG}; pg8::gemm_phase<EpiG2, OneUnit, true, true>(ldsb, g, S, E);
            if (BOTH(4) && MK_ONE_LAUNCH) xcd_barrier_wait(bar);
        } else {
            const int nsb = (int)gridDim.x > N_SGEMM_WG ? (int)gridDim.x - N_SGEMM_WG : (int)gridDim.x, sidx = (int)gridDim.x > N_SGEMM_WG ? (int)blockIdx.x - N_SGEMM_WG : (int)blockIdx.x;
            if ((int)gridDim.x == 256) {
                __syncthreads();
                attn_prompt_unit(ldsb, 4 * 256 + (int)blockIdx.x, QA, KA, VA, OG, LSE, tid, wave, lane);
                attn_prompt_unit(ldsb, 5 * 256 + (int)blockIdx.x, QA, KA, VA, OG, LSE, tid, wave, lane);
                if (sidx < 32) attn_prompt_unit(ldsb, (4 + (sidx >> 4)) * 256 + (sidx & 15), QA, KA, VA, OG, LSE, tid, wave, lane);
            }
            if (BOTH(4) && MK_ONE_LAUNCH) xcd_barrier_wait(bar);
            const int nch = NP * 4 * 128 * 32, cpb = (nch + nsb - 1) / nsb;
            for (int q = sidx * cpb + tid; q < nch && q < (sidx + 1) * cpb; q += NTHR) {
                const int f4 = (q & 31) * 4, i = (q >> 5) & 127, nh = q >> 12;
                f32x4 st = (f32x4){0.f, 0.f, 0.f, 0.f};
#pragma unroll 1
                for (int c0 = 0; c0 < 64; c0 += 16) {
                    v2u dsv[16]; f32x4 dcv[16];
#pragma unroll
                    for (int k = 0; k < 16; ++k) { const size_t it = (size_t)nh * 64 + c0 + k;
                        dsv[k] = *(const v2u*)((const bf16*)DS + (it * 128 + i) * 128 + f4); dcv[k] = *(const f32x4*)(DEC + it * 128 + f4); }
#pragma unroll
                    for (int k = 0; k < 16; ++k) { const size_t it = (size_t)nh * 64 + c0 + k;
                        st = dcv[k] * st + (f32x4){bflo(dsv[k].x), bfhi(dsv[k].x), bflo(dsv[k].y), bfhi(dsv[k].y)};
                        if (c0 + k < 63) { v2u w; w.x = pk2(st[0], st[1]); w.y = pk2(st[2], st[3]); *(v2u*)(SB + ((it + 1) * 128 + i) * 128 + f4) = w; } }
                }
#pragma unroll
                for (int e = 0; e < 4; ++e) out[O_HP + ((size_t)nh * 128 + f4 + e) * 128 + i] = st[e];
            }
        }
        if (BOTH(5)) GRID_BAR();
    }
    if (IN(6)) {
        const bool sg = (int)blockIdx.x < N_SGEMM_WG && (int)gridDim.x > N_SGEMM_WG;
        if (sg) {
            const OneUnit S{MP / 256 + ((int)blockIdx.x >> 2), (int)blockIdx.x & 3};
            pg8::Gemm g{MG, WOT, M, D, D}; EpiY E{out, x_p, x_s, ADA};
            pg8::gemm_phase<EpiY, OneUnit, true, true>(ldsb, g, S, E);
            { HcPre P; hgrn_phaseC_prefetch(P, 2 * (int)blockIdx.x, LF, QB, IB, SB, tid);
              for (int k = 0; k < 2; ++k) hgrn_phaseC_item(ldsb, 2 * (int)blockIdx.x + k, P, k + 1 < 2, 2 * (int)blockIdx.x + k + 1, LF, QB, IB, ZB, SB, o_gain, OB, tid, wave, lane); }
        } else if ((int)gridDim.x == 256) {
            const int sidx = (int)blockIdx.x - N_SGEMM_WG;
            const int nit = sidx < 32 ? 5 : 4, it0 = 32 + (sidx < 32 ? 5 * sidx : 160 + 4 * (sidx - 32));
            { HcPre P; hgrn_phaseC_prefetch(P, it0, LF, QB, IB, SB, tid);
              for (int k = 0; k < nit; ++k) hgrn_phaseC_item(ldsb, it0 + k, P, k + 1 < nit, it0 + k + 1, LF, QB, IB, ZB, SB, o_gain, OB, tid, wave, lane); }
            if (sidx >= 32) for (int r = (sidx - 32) * NWAVES + wave; r < MP; r += 208 * NWAVES) combine_row(r, lane, true, OG, LSE, ZA, OA);
        } else {
            const int nsb = (int)gridDim.x > N_SGEMM_WG ? (int)gridDim.x - N_SGEMM_WG : (int)gridDim.x, sidx = (int)gridDim.x > N_SGEMM_WG ? (int)blockIdx.x - N_SGEMM_WG : (int)blockIdx.x;
            { HcPre P; for (int it = sidx; it < N_HG_ITEMS; it += nsb) { hgrn_phaseC_prefetch(P, it, LF, QB, IB, SB, tid); hgrn_phaseC_item(ldsb, it, P, false, 0, LF, QB, IB, ZB, SB, o_gain, OB, tid, wave, lane); } }
            for (int r = sidx * NWAVES + wave; r < MP; r += nsb * NWAVES) combine_row(r, lane, true, OG, LSE, ZA, OA);
        }
        if (BOTH(6)) GRID_BAR();
    }
    if (IN(7)) {
        { pg8::Gemm g{OA, WAT, MP, D, D}; pg8::StaticOrder S; S.init(MP, D, gridDim.x, (int)blockIdx.x); EpiG2 E{GA, GB, MG};
          pg8::gemm_phase<EpiG2, pg8::StaticOrder, false, true>(ldsb, g, S, E); }
        if (BOTH(7)) GRID_BAR();
    }
    if (IN(8)) {
        pg8::Gemm g{MG, WOT, MP, D, D}; pg8::StaticOrder S; S.init(MP, D, gridDim.x, (int)blockIdx.x); EpiY E{out, x_p, x_s, ADA};
        pg8::gemm_phase<EpiY, pg8::StaticOrder, false, true>(ldsb, g, S, E);
    }
#undef IN
#undef BOTH
}

extern "C" void kernel_launch(void* const* d_in, const int* in_sizes, int n_in, void* d_out, int out_size, void* d_ws, size_t ws_size, hipStream_t stream) {
    static int grid = 0;
    if (grid == 0) {
        if (n_in != 19 || (size_t)out_size != O_END || ws_size < WS_END) { fprintf(stderr, "kernel_launch: unexpected shapes (n_in %d out %d ws %zu)\n", n_in, out_size, ws_size); grid = -1; return; }
        int dev = 0, cus = 0, per_cu = 0;
        if (hipGetDevice(&dev) != hipSuccess || hipDeviceGetAttribute(&cus, hipDeviceAttributeMultiprocessorCount, dev) != hipSuccess) { grid = -1; return; }
        if (hipFuncSetAttribute((const void*)fwd, hipFuncAttributeMaxDynamicSharedMemorySize, LDS_BYTES) != hipSuccess) { fprintf(stderr, "kernel_launch: hipFuncSetAttribute failed\n"); grid = -1; return; }
        if (hipOccupancyMaxActiveBlocksPerMultiprocessor(&per_cu, (const void*)fwd, NTHR, LDS_BYTES) != hipSuccess || per_cu < 1) { fprintf(stderr, "kernel_launch: occupancy query says %d\n", per_cu); }
        (void)hipGetLastError();
        if (cus < 2 * NS) { fprintf(stderr, "kernel_launch: built for a 256-CU device (one workgroup per CU, 256 workgroups); found %d CUs\n", cus); grid = -1; return; }
        grid = 2 * NS;
    }
    if (grid < 0) return;
    hipMemsetAsync((char*)d_ws + WS_CTL, 0, CTL_ZERO_BYTES, stream);
    Args a{};
    for (int i = 0; i < 19; ++i) a.in[i] = (const float*)d_in[i];
    a.out = (float*)d_out; a.ws = (unsigned char*)d_ws;
#if MK_ONE_LAUNCH
    a.ph_lo = 0; a.ph_hi = NPHASE;
    hipLaunchKernelGGL(fwd, dim3(grid), dim3(NTHR), LDS_BYTES, stream, a);
#else
    for (int ph = 0; ph < NPHASE; ++ph) { a.ph_lo = ph; a.ph_hi = ph + 1; hipLaunchKernelGGL(fwd, dim3(grid), dim3(NTHR), LDS_BYTES, stream, a); }
#endif
}
```

```cpp
#include <hip/hip_runtime.h>
#include <cstdio>
#include <cstdint>

constexpr int D = 1024, NP = 4, TP = 4096, NS = 128, TS = 8;
constexpr int MP = NP * TP, MS = NS * TS, M = MP + MS;
constexpr int NIN = 9216;
constexpr int C_QA = 0, C_KA = 1536, C_VA = 3072, C_ZA = 4608, C_QB = 5120, C_FB = 5632, C_IB = 6144, C_ZB = 6656, C_GA = 7168, C_GB = 8192;
constexpr int NSEQ = NP + NS;
constexpr float EPS = 1e-6f;
constexpr int NTHR = 512, NWAVES = 8;

constexpr size_t O_YP = 0, O_YS = O_YP + (size_t)MP * D, O_KVP0 = O_YS + (size_t)MS * D, O_KVP1 = O_KVP0 + (size_t)NP * 128 * 1024,
                 O_KVP2 = O_KVP1 + (size_t)NP * 512 * 1024, O_HP = O_KVP2 + (size_t)NP * 2048 * 1024, O_KVS0 = O_HP + (size_t)NP * 4 * 128 * 128,
                 O_KVS1 = O_KVS0 + (size_t)MS * 1024, O_KVS2 = O_KVS1 + (size_t)MS * 1024, O_HS = O_KVS2 + (size_t)MS * 1024, O_END = O_HS + (size_t)NS * 4 * 128 * 128;

constexpr size_t MiB = 1u << 20;
constexpr size_t WS_CTL = 0, CTL_ZERO_BYTES = 1 * MiB;
constexpr size_t WS_ADA = 1 * MiB;
constexpr size_t WS_LB = 3 * MiB;
constexpr size_t WS_W1T = 4 * MiB;
constexpr size_t WS_WAT = 22 * MiB;
constexpr size_t WS_WBT = 23 * MiB;
constexpr size_t WS_WOT = 24 * MiB;
constexpr size_t WS_H = 26 * MiB;
constexpr size_t WS_QA = 64 * MiB;
constexpr size_t WS_KA = 116 * MiB;
constexpr size_t WS_VA = 168 * MiB;
constexpr size_t WS_ZA = 220 * MiB;
constexpr size_t WS_QB = 238 * MiB;
constexpr size_t WS_IB = 256 * MiB;
constexpr size_t WS_ZB = 274 * MiB;
constexpr size_t WS_LF = 292 * MiB;
constexpr size_t WS_GA = 328 * MiB;
constexpr size_t WS_GB = 364 * MiB;
constexpr size_t WS_OA = 400 * MiB;
constexpr size_t WS_OBR = 436 * MiB;
constexpr size_t WS_MGF = 472 * MiB;
constexpr size_t WS_MG = 542 * MiB;
constexpr size_t WS_OG = 578 * MiB;
constexpr size_t WS_LSE = 630 * MiB;
constexpr size_t WS_DS = 634 * MiB;
constexpr size_t WS_DEC = 698 * MiB;
constexpr size_t WS_SB = 700 * MiB;
constexpr size_t WS_END = 732 * MiB;
constexpr float QSCALE = 0.125f * 1.4426950408889634f;
constexpr float LOG2E = 1.4426950408889634f;
constexpr int CW_ADA = 1024;
constexpr int CW_BAR = 4096;

constexpr int RING_BYTES = 131072, MISC_OFF = RING_BYTES + 320, LDS_BYTES = 147456;

#define GAS __attribute__((address_space(1)))
#define LAS __attribute__((address_space(3)))
typedef unsigned short bf16;
typedef unsigned v4u __attribute__((ext_vector_type(4)));
typedef unsigned v2u __attribute__((ext_vector_type(2)));

namespace pg8 {
#define PG8_LAS __attribute__((address_space(3)))
typedef unsigned short bf16_t;
typedef short bf16x8 __attribute__((ext_vector_type(8)));
typedef float f32x4 __attribute__((ext_vector_type(4)));
typedef unsigned u32x4 __attribute__((ext_vector_type(4)));
constexpr int BM = 256, BK = 64, HALF = 128, HTB = HALF * BK * 2  , STAGE_BYTES = 8 * HTB, NXCD = 8, WGM = 8;

__host__ __device__ __forceinline__ int lds_byte(int r, int c) { const int st = (r >> 4) * 2 + (c >> 5), rr = r & 15, cc = c & 31, ob = rr * 64 + cc * 2; return st * 1024 + (ob ^ (((ob >> 9) & 1) << 5)); }
__host__ __device__ __forceinline__ void stage_rc(int b, int& R, int& C) { const int st = b / 1024, sb = b % 1024, swz = sb ^ (((sb >> 9) & 1) << 5); R = (st >> 1) * 16 + swz / 64; C = (st & 1) * 32 + (swz % 64) / 2; }
__host__ __device__ __forceinline__ int perm32(int rho) { const int n = rho >> 4, i = rho & 15; return 8 * (i >> 2) + 4 * n + (i & 3); }

struct Unit { int pm, pn; };
struct Gemm { const bf16_t* A; const bf16_t* Bt; int M, N, K; };

struct StaticOrder {
    int nM, nN, nwg, G, c;
    __host__ __device__ void init(int M, int N, int G_, int c_) { nM = M / BM; nN = N / BM; nwg = nM * nN; G = G_; c = c_; }
    __host__ __device__ bool next(int i, Unit& u) const {
        const long L = (long)i * G + c; if (L >= nwg) return false;
        int wgid = (int)L; { const int q = nwg / NXCD, r = nwg % NXCD, xcd = wgid % NXCD, off = wgid / NXCD; wgid = (xcd < r ? xcd * (q + 1) : r * (q + 1) + (xcd - r) * q) + off; }
        const int nig = WGM * nN, gid = wgid / nig, fm = gid * WGM, gsz = (nM - fm) < WGM ? (nM - fm) : WGM;
        u.pm = fm + ((wgid % nig) % gsz); u.pn = (wgid % nig) / gsz; return true;
    }
    __device__ __forceinline__ void a_ready(const Unit&) const {}
    __device__ __forceinline__ void done(const Unit&) const {}
};

__device__ __forceinline__ unsigned cvt_pk_bf16(float lo, float hi) { unsigned r; asm volatile("v_cvt_pk_bf16_f32 %0, %1, %2" : "=v"(r) : "v"(lo), "v"(hi)); return r; }
template <class E, class = void> struct pg8_has_midk { static constexpr bool value = false; };
template <class E> struct pg8_has_midk<E, decltype((void)E::MIDK)> { static constexpr bool value = E::MIDK; };
template <class Epi, class Sched, bool ALIGN_EPI = false, bool SP2 = false>
__device__ __forceinline__ void gemm_phase(PG8_LAS unsigned char* lds, const Gemm g, const Sched& S, const Epi& E) {
    const int tid = threadIdx.x, wid = __builtin_amdgcn_readfirstlane(tid >> 6), lane = tid & 63, wr = wid >> 2, wc = wid & 3, fr = lane & 15, fq = lane >> 4;
    const int K = g.K, nt = K / BK;
    unsigned voffA[2], voffB[2];
#pragma unroll
    for (int i = 0; i < 2; ++i) { int R, C; stage_rc(tid * 16 + i * 8192, R, C); const int Rb = Epi::PERM ? ((R & ~31) + perm32(R & 31)) : R;
        voffA[i] = (unsigned)(R * K + C) * 2u; voffB[i] = (unsigned)(Rb * K + C) * 2u; }
    const size_t kstep = (size_t)(BK * 2);
    const size_t hstep = (size_t)HALF * K * 2;
    const size_t tstep = 2 * hstep;
    const unsigned ldsw = (unsigned)wid * 1024u;
    const int aoff = lds_byte(wr * 64 + fr, fq * 8), boff = lds_byte(wc * 32 + fr, fq * 8);
#define PG8_SA(b, h) (((b) * 2 + (h)) * HTB)
#define PG8_SB(b, h) ((4 + (b) * 2 + (h)) * HTB)
#define PG8_STAGE(bufoff, gbase, voff) do { _Pragma("unroll") for (int _i = 0; _i < 2; ++_i) \
        __builtin_amdgcn_global_load_lds((const unsigned*)((const char*)(gbase) + (voff)[_i]), (PG8_LAS unsigned*)(lds + (bufoff) + ldsw + _i * 8192), 16, 0, 0); } while (0)
#define PG8_LDA(dst, b, h) do { _Pragma("unroll") for (int m = 0; m < 4; ++m) _Pragma("unroll") for (int k = 0; k < 2; ++k) dst[m][k] = *(const PG8_LAS bf16x8*)(lds + PG8_SA(b, h) + aoff + m * 2048 + k * 1024); } while (0)
#define PG8_LDB(dst, b, h) do { _Pragma("unroll") for (int n = 0; n < 2; ++n) _Pragma("unroll") for (int k = 0; k < 2; ++k) dst[n][k] = *(const PG8_LAS bf16x8*)(lds + PG8_SB(b, h) + boff + n * 2048 + k * 1024); } while (0)
#define PG8_MMA(ai, bj, At, Bt) do { __builtin_amdgcn_s_setprio(1); _Pragma("unroll") for (int m = 0; m < 4; ++m) _Pragma("unroll") for (int n = 0; n < 2; ++n) _Pragma("unroll") for (int k = 0; k < 2; ++k) \
        acc[ai][bj][m][n] = __builtin_amdgcn_mfma_f32_16x16x32_bf16(Bt[n][k], At[m][k], acc[ai][bj][m][n], 0, 0, 0); __builtin_amdgcn_s_setprio(0); } while (0)
#define PG8_WAIT_V(n) asm volatile("s_waitcnt vmcnt(" #n ")" ::: "memory")
#define PG8_WAIT_L(n) asm volatile("s_waitcnt lgkmcnt(" #n ")" ::: "memory")
#define PG8_BAR __builtin_amdgcn_s_barrier()
#define PG8_SCHED __builtin_amdgcn_sched_barrier(0)
    Unit cur, nxt; int ui = 0;
    if (!S.next(0, cur)) return;
    f32x4 acc[2][2][4][2];
#pragma unroll
    for (int a = 0; a < 2; ++a)
#pragma unroll
        for (int b = 0; b < 2; ++b)
#pragma unroll
            for (int m = 0; m < 4; ++m)
#pragma unroll
                for (int n = 0; n < 2; ++n) acc[a][b][m][n] = (f32x4){0.f, 0.f, 0.f, 0.f};
    bf16x8 At[4][2], B0[2][2], B1[2][2];
    const char* cA = (const char*)g.A + (size_t)cur.pm * tstep; const char* cB = (const char*)g.Bt + (size_t)cur.pn * tstep;
    S.a_ready(cur);
    if constexpr (SP2) {
        PG8_STAGE(PG8_SB(0, 0), cB, voffB); PG8_STAGE(PG8_SB(0, 1), cB + hstep, voffB); PG8_STAGE(PG8_SA(0, 0), cA, voffA); PG8_STAGE(PG8_SA(0, 1), cA + hstep, voffA);
        if (wr == 1) PG8_BAR;
        PG8_WAIT_V(2); PG8_BAR;
        PG8_STAGE(PG8_SB(1, 0), cB + kstep, voffB); PG8_STAGE(PG8_SA(1, 0), cA + kstep, voffA); PG8_STAGE(PG8_SB(1, 1), cB + hstep + kstep, voffB);
        PG8_WAIT_V(6); PG8_BAR;
    } else {
        PG8_STAGE(PG8_SB(0, 0), cB, voffB); PG8_STAGE(PG8_SA(0, 0), cA, voffA); PG8_STAGE(PG8_SB(0, 1), cB + hstep, voffB); PG8_STAGE(PG8_SA(0, 1), cA + hstep, voffA);
        if (wr == 1) PG8_BAR;
        PG8_WAIT_V(4); PG8_BAR;
        PG8_STAGE(PG8_SB(1, 0), cB + kstep, voffB); PG8_STAGE(PG8_SA(1, 0), cA + kstep, voffA); PG8_STAGE(PG8_SB(1, 1), cB + hstep + kstep, voffB);
        PG8_WAIT_V(6); PG8_BAR;
    }
    for (;;) {
        const bool has_next = S.next(ui + 1, nxt);
        const char* nA = has_next ? (const char*)g.A + (size_t)nxt.pm * tstep : cA; const char* nB = has_next ? (const char*)g.Bt + (size_t)nxt.pn * tstep : cB;
        for (int t = 0; t < nt; t += 2) {
            const bool last = (t == nt - 2);
            const char* a1 = cA + (size_t)(t + 1) * kstep;
            const char* a2 = last ? nA : cA + (size_t)(t + 2) * kstep; const char* b2 = last ? nB : cB + (size_t)(t + 2) * kstep;
            const char* a3 = a2 + kstep; const char* b3 = b2 + kstep;
            if (last && has_next) S.a_ready(nxt);
            if constexpr (pg8_has_midk<Epi>::value) { if (t == nt / 2) { int z = t - nt / 2; asm volatile("" : "+s"(z)); E.mid(acc, cur, wr, wc, fr, fq, z); } }
            if constexpr (SP2) {
            PG8_LDB(B0, 0, 0); PG8_LDB(B1, 0, 1); PG8_SCHED; PG8_LDA(At, 0, 0); PG8_STAGE(PG8_SA(1, 1), a1 + hstep, voffA);
            PG8_WAIT_V(8); PG8_WAIT_L(0); PG8_BAR; PG8_MMA(0, 0, At, B0); PG8_MMA(0, 1, At, B1); PG8_BAR; PG8_SCHED;
            PG8_LDA(At, 0, 1); PG8_STAGE(PG8_SB(0, 0), b2, voffB); PG8_STAGE(PG8_SB(0, 1), b2 + hstep, voffB); PG8_STAGE(PG8_SA(0, 0), a2, voffA);
            PG8_WAIT_V(8); PG8_WAIT_L(0); PG8_BAR; PG8_MMA(1, 0, At, B0); PG8_MMA(1, 1, At, B1); PG8_BAR; PG8_SCHED;
            PG8_LDB(B0, 1, 0); PG8_LDB(B1, 1, 1); PG8_SCHED; PG8_LDA(At, 1, 0); PG8_STAGE(PG8_SA(0, 1), a2 + hstep, voffA);
            PG8_WAIT_V(8); PG8_WAIT_L(0); PG8_BAR; PG8_MMA(0, 0, At, B0); PG8_MMA(0, 1, At, B1); PG8_BAR; PG8_SCHED;
            PG8_LDA(At, 1, 1); PG8_STAGE(PG8_SB(1, 0), b3, voffB); PG8_STAGE(PG8_SB(1, 1), b3 + hstep, voffB); PG8_STAGE(PG8_SA(1, 0), a3, voffA);
            PG8_WAIT_V(8); PG8_WAIT_L(0); PG8_BAR; PG8_MMA(1, 0, At, B0); PG8_MMA(1, 1, At, B1); PG8_BAR; PG8_SCHED;
            } else {
            PG8_LDB(B0, 0, 0); PG8_SCHED; PG8_LDA(At, 0, 0); PG8_STAGE(PG8_SA(1, 1), a1 + hstep, voffA);
            PG8_WAIT_L(8); PG8_BAR; PG8_WAIT_L(0); PG8_MMA(0, 0, At, B0); PG8_BAR; PG8_SCHED;
            PG8_LDB(B1, 0, 1); PG8_STAGE(PG8_SB(0, 0), b2, voffB);
            PG8_BAR; PG8_WAIT_L(0); PG8_MMA(0, 1, At, B1); PG8_BAR;
            PG8_LDA(At, 0, 1); PG8_STAGE(PG8_SA(0, 0), a2, voffA);
            PG8_BAR; PG8_WAIT_L(0); PG8_MMA(1, 0, At, B0); PG8_BAR; PG8_SCHED;
            PG8_STAGE(PG8_SB(0, 1), b2 + hstep, voffB);
            PG8_WAIT_V(6); PG8_BAR; PG8_MMA(1, 1, At, B1); PG8_BAR;
            PG8_LDB(B0, 1, 0); PG8_SCHED; PG8_LDA(At, 1, 0); PG8_STAGE(PG8_SA(0, 1), a2 + hstep, voffA);
            PG8_WAIT_L(8); PG8_BAR; PG8_WAIT_L(0); PG8_MMA(0, 0, At, B0); PG8_BAR; PG8_SCHED;
            PG8_LDB(B1, 1, 1); PG8_STAGE(PG8_SB(1, 0), b3, voffB);
            PG8_BAR; PG8_WAIT_L(0); PG8_MMA(0, 1, At, B1); PG8_BAR;
            PG8_LDA(At, 1, 1); PG8_STAGE(PG8_SA(1, 0), a3, voffA);
            PG8_BAR; PG8_WAIT_L(0); PG8_MMA(1, 0, At, B0); PG8_BAR; PG8_SCHED;
            PG8_STAGE(PG8_SB(1, 1), b3 + hstep, voffB);
            PG8_WAIT_V(6); PG8_BAR; PG8_MMA(1, 1, At, B1); PG8_BAR;
            }
        }
        if constexpr (ALIGN_EPI) { if (wr == 0) PG8_BAR; }
        if constexpr (!Epi::AFTER_DRAIN) { E(acc, cur, wr, wc, fr, fq); S.done(cur); }
        if (!has_next) break;
#pragma unroll
        for (int a = 0; a < 2; ++a)
#pragma unroll
            for (int b = 0; b < 2; ++b)
#pragma unroll
                for (int m = 0; m < 4; ++m)
#pragma unroll
                    for (int n = 0; n < 2; ++n) acc[a][b][m][n] = (f32x4){0.f, 0.f, 0.f, 0.f};
        cur = nxt; cA = nA; cB = nB; ++ui;
        if constexpr (ALIGN_EPI) { if (wr == 1) PG8_BAR; }
    }
    PG8_WAIT_V(0);
    if constexpr (!ALIGN_EPI) { if (wr == 0) PG8_BAR; }
    PG8_BAR;
    if constexpr (Epi::AFTER_DRAIN) { E.fused(acc, cur, wr, wc, fr, fq, lds, wid, lane); S.done(cur); }
#undef PG8_SA
#undef PG8_SB
#undef PG8_STAGE
#undef PG8_LDA
#undef PG8_LDB
#undef PG8_MMA
#undef PG8_WAIT_V
#undef PG8_WAIT_L
#undef PG8_BAR
#undef PG8_SCHED
}
}
#define XB_TMO      128
#define XB_XCNT(j)  (256  + 64 * (j))
#define XB_XSUB(j)  (1280 + 64 * (j))
#define XB_XGEN(j)  (2304 + 64 * (j))
#define XB_TOP      3328
#define XB_TOPGEN   3392
#define XCD_BAR_WORDS 3456
#define XB_SPIN_CAP (1u << 18)
#define LAS __attribute__((address_space(3)))

__device__ __forceinline__ unsigned xb_ld(unsigned* p)              { return __hip_atomic_load(p, __ATOMIC_RELAXED, __HIP_MEMORY_SCOPE_AGENT); }
__device__ __forceinline__ unsigned xb_add(unsigned* p, unsigned v) { return __hip_atomic_fetch_add(p, v, __ATOMIC_RELAXED, __HIP_MEMORY_SCOPE_AGENT); }
__device__ __forceinline__ unsigned xb_xcc_id() { return (unsigned)__builtin_amdgcn_s_getreg((3 << 11) | 20) & 0xFu; }
#define XB_SPIN(cond, bar) do { unsigned _sp = 0; while (cond) { __builtin_amdgcn_s_sleep(1); \
    if ((++_sp & 255u) == 0u) { if (xb_ld(&(bar)[XB_TMO])) break; if (_sp > XB_SPIN_CAP) { atomicAdd(&(bar)[XB_TMO], 1u); break; } } } } while (0)

struct XcdBarrier {
    unsigned* bar; unsigned x;
    volatile LAS unsigned* st;
};

__device__ __forceinline__ XcdBarrier xcd_barrier_post(unsigned* bar, volatile LAS unsigned* st) {
    XcdBarrier b; b.bar = bar; b.x = xb_xcc_id(); b.st = st;
    if (threadIdx.x == 0) (void)xb_add(&bar[XB_XCNT(b.x)], 1u);
    return b;
}
__device__ __forceinline__ void xcd_barrier_complete(unsigned* bar, unsigned x, unsigned& nloc, unsigned& nx) {
    const unsigned G = gridDim.x * gridDim.y * gridDim.z;
    unsigned sum, cnt, mine, sp = 0u;
    for (;;) {
        sum = 0u; cnt = 0u; mine = 0u;
#pragma unroll
        for (unsigned j = 0; j < 16; ++j) { const unsigned c = xb_ld(&bar[XB_XCNT(j)]); sum += c; cnt += (c > 0u) ? 1u : 0u; mine = (j == x) ? c : mine; }
        if (sum == G) break;
        __builtin_amdgcn_s_sleep(1);
        if ((++sp & 255u) == 0u) { if (xb_ld(&bar[XB_TMO])) break; if (sp > XB_SPIN_CAP) { atomicAdd(&bar[XB_TMO], 1u); break; } }
    }
    nloc = mine > 0u ? mine : 1u; nx = cnt > 0u ? cnt : 1u;
}

__device__ __forceinline__ void xcd_barrier(const XcdBarrier& b) {
    asm volatile("s_waitcnt vmcnt(0)" ::: "memory");
    __syncthreads();
    if (threadIdx.x == 0) {
        unsigned* bar = b.bar;
        __builtin_amdgcn_s_waitcnt(0);
        unsigned nloc = b.st[0], nx = b.st[1];
        if (nloc == 0u) { xcd_barrier_complete(bar, b.x, nloc, nx); b.st[0] = nloc; b.st[1] = nx; }
        const unsigned old = xb_add(&bar[XB_XSUB(b.x)], 1u);
        const unsigned gen = old / nloc;
        if (old + 1u == (gen + 1u) * nloc) {
            __builtin_amdgcn_fence(__ATOMIC_RELEASE, "agent");
            asm volatile("s_waitcnt vmcnt(0)" ::: "memory");
            const unsigned og = xb_add(&bar[XB_TOP], 1u);
            const unsigned tg = og / nx;
            if (og + 1u == (tg + 1u) * nx) xb_add(&bar[XB_TOPGEN], 1u);
            else XB_SPIN(xb_ld(&bar[XB_TOPGEN]) == tg, bar);
            __builtin_amdgcn_fence(__ATOMIC_ACQUIRE, "agent");
            xb_add(&bar[XB_XGEN(b.x)], 1u);
            asm volatile("s_waitcnt vmcnt(0)" ::: "memory");
        } else {
            XB_SPIN(xb_ld(&bar[XB_XGEN(b.x)]) == gen, bar);
            __builtin_amdgcn_fence(__ATOMIC_ACQUIRE, "agent");
            asm volatile("s_waitcnt vmcnt(0)" ::: "memory");
        }
    }
    __syncthreads();
}

__device__ __forceinline__ void xcd_barrier_arrive(const XcdBarrier& b) {
    asm volatile("s_waitcnt vmcnt(0)" ::: "memory");
    __syncthreads();
    if (threadIdx.x == 0) {
        unsigned* bar = b.bar;
        __builtin_amdgcn_s_waitcnt(0);
        unsigned nloc = b.st[0], nx = b.st[1];
        if (nloc == 0u) { xcd_barrier_complete(bar, b.x, nloc, nx); b.st[0] = nloc; b.st[1] = nx; }
        const unsigned old = xb_add(&bar[XB_XSUB(b.x)], 1u);
        const unsigned gen = old / nloc;
        if (old + 1u == (gen + 1u) * nloc) {
            __builtin_amdgcn_fence(__ATOMIC_RELEASE, "agent");
            asm volatile("s_waitcnt vmcnt(0)" ::: "memory");
            const unsigned og = xb_add(&bar[XB_TOP], 1u);
            const unsigned tg = og / nx;
            if (og + 1u == (tg + 1u) * nx) xb_add(&bar[XB_TOPGEN], 1u);
            else XB_SPIN(xb_ld(&bar[XB_TOPGEN]) == tg, bar);
            __builtin_amdgcn_fence(__ATOMIC_ACQUIRE, "agent");
            xb_add(&bar[XB_XGEN(b.x)], 1u);
            asm volatile("s_waitcnt vmcnt(0)" ::: "memory");
            b.st[2] = 0u;
        } else { b.st[2] = 1u; b.st[3] = gen; }
    }
}
__device__ __forceinline__ void xcd_barrier_wait(const XcdBarrier& b) {
    if (threadIdx.x == 0) {
        if (b.st[2] != 0u) {
            unsigned* bar = b.bar; const unsigned gen = b.st[3];
            XB_SPIN(xb_ld(&bar[XB_XGEN(b.x)]) == gen, bar);
            __builtin_amdgcn_fence(__ATOMIC_ACQUIRE, "agent");
            asm volatile("s_waitcnt vmcnt(0)" ::: "memory");
            b.st[2] = 0u;
        }
    }
    __syncthreads();
}


typedef float f32x4 __attribute__((ext_vector_type(4)));
typedef float f32x2 __attribute__((ext_vector_type(2)));
typedef _Float16 lf_t;
typedef _Float16 lf_x4 __attribute__((ext_vector_type(4)));
__device__ __forceinline__ float wave_sum(float v) {
#pragma unroll
    for (int o = 1; o < 64; o <<= 1) v += __shfl_xor(v, o);
    return v;
}
__device__ __forceinline__ float wave_max(float v) {
#pragma unroll
    for (int o = 1; o < 64; o <<= 1) v = fmaxf(v, __shfl_xor(v, o));
    return v;
}
__device__ __forceinline__ float fexp2(float x) { return __builtin_amdgcn_exp2f(x); }
__device__ __forceinline__ float fexp(float x) { return __builtin_amdgcn_exp2f(x * 1.4426950408889634f); }
__device__ __forceinline__ float flog2(float x) { return __builtin_amdgcn_logf(x); }
__device__ __forceinline__ float frcp(float x) { return __builtin_amdgcn_rcpf(x); }
__device__ __forceinline__ float frsq(float x) { return __builtin_amdgcn_rsqf(x); }
__device__ __forceinline__ float sigmoidf_(float x) { return frcp(1.0f + fexp(-x)); }
__device__ __forceinline__ float siluf_(float x) { return x * frcp(1.0f + fexp(-x)); }
__device__ __forceinline__ int seq_of_row(int r) { return r < MP ? r / TP : NP + (r - MP) / TS; }
typedef __bf16 hwbf2 __attribute__((ext_vector_type(2)));
__device__ __forceinline__ unsigned f2bf(float f) { return (unsigned)__builtin_bit_cast(unsigned short, (__bf16)f); }
__device__ __forceinline__ unsigned pk2(float lo, float hi) { hwbf2 v; v[0] = (__bf16)lo; v[1] = (__bf16)hi; return __builtin_bit_cast(unsigned, v); }
__host__ __device__ __forceinline__ int phys_row(int n) { return (n & ~255) + ((n >> 5) & 1) * 128 + ((n >> 6) & 3) * 32 + (n & 31); }

__device__ __forceinline__ float bf2f(unsigned short b) { return __builtin_bit_cast(float, (unsigned)b << 16); }
__device__ __forceinline__ float bflo(unsigned w) { return __builtin_bit_cast(float, w << 16); }
__device__ __forceinline__ float bfhi(unsigned w) { return __builtin_bit_cast(float, w & 0xffff0000u); }
struct EpiIn {
    static constexpr bool PERM = true, AFTER_DRAIN = false;
    unsigned char* ws; bf16 *QA, *KA, *VA; _Float16* LF; float* out; const float* q_gain; const float* k_gain; const float* LB;
    __device__ __forceinline__ void operator()(const pg8::f32x4 (&acc)[2][2][4][2], const pg8::Unit& u, int wr, int wc, int fr, int fq) const {
        const int row0 = u.pm * 256 + wr * 64 + fr, pn = u.pn, cw = wc * 64 + fq * 8;
        const bool prompt_unit = u.pm < MP / 256;
        if (pn < 12) {
            const bool isk = pn >= 6; const int hd = (isk ? pn - 6 : pn) * 4 + wc, g = hd >> 3, j = hd & 7;
            const float* gp = (isk ? k_gain : q_gain) + fq * 8;
            float gn[2][2][4];
#pragma unroll
            for (int bj = 0; bj < 2; ++bj)
#pragma unroll
                for (int n = 0; n < 2; ++n) { const pg8::f32x4 t = *(const pg8::f32x4*)(gp + bj * 32 + n * 4);
#pragma unroll
                    for (int jj = 0; jj < 4; ++jj) gn[bj][n][jj] = t[jj] * (isk ? 1.0f : QSCALE); }
            const int W = g == 0 ? 128 : (g == 1 ? 512 : 2048);
            const size_t okvp = g == 0 ? O_KVP0 : (g == 1 ? O_KVP1 : O_KVP2), okvs = g == 0 ? O_KVS0 : (g == 1 ? O_KVS1 : O_KVS2);
#pragma unroll
            for (int ai = 0; ai < 2; ++ai)
#pragma unroll
                for (int m = 0; m < 4; ++m) { const int row = row0 + ai * 128 + m * 16;
                    float ss = 0.f;
#pragma unroll
                    for (int bj = 0; bj < 2; ++bj)
#pragma unroll
                        for (int n = 0; n < 2; ++n) { const pg8::f32x4 v = acc[ai][bj][m][n]; ss += (v[0] * v[0] + v[1] * v[1]) + (v[2] * v[2] + v[3] * v[3]); }
                    ss += __shfl_xor(ss, 16); ss += __shfl_xor(ss, 32);
                    const float rstd = frsq(ss * (1.0f / 64.f) + EPS);
                    float* kvd = nullptr;
                    if (isk) { if (row < MP) { const int nn = row / TP, t = row % TP; if (t >= TP - W) kvd = out + okvp + ((size_t)nn * W + (t - (TP - W))) * 1024 + j * 64 + fq * 8; }
                               else kvd = out + okvs + (size_t)(row - MP) * 1024 + j * 64 + fq * 8; }
                    bf16* dst = (isk ? KA : QA) + (size_t)row * 1536 + hd * 64 + fq * 8;
#pragma unroll
                    for (int bj = 0; bj < 2; ++bj) { float o[8];
#pragma unroll
                        for (int n = 0; n < 2; ++n)
#pragma unroll
                            for (int jj = 0; jj < 4; ++jj) o[n * 4 + jj] = acc[ai][bj][m][n][jj] * rstd * gn[bj][n][jj];
                        v4u w; w.x = pk2(o[0], o[1]); w.y = pk2(o[2], o[3]); w.z = pk2(o[4], o[5]); w.w = pk2(o[6], o[7]);
                        if (!isk || prompt_unit) *(v4u*)(dst + bj * 32) = w;
                        if (kvd) { *(pg8::f32x4*)(kvd + bj * 32) = (pg8::f32x4){o[0], o[1], o[2], o[3]}; *(pg8::f32x4*)(kvd + bj * 32 + 4) = (pg8::f32x4){o[4], o[5], o[6], o[7]}; } } }
        } else if (pn < 18) {
            const int hd = (pn - 12) * 4 + wc, g = hd >> 3, j = hd & 7;
            const int W = g == 0 ? 128 : (g == 1 ? 512 : 2048);
            const size_t okvp = g == 0 ? O_KVP0 : (g == 1 ? O_KVP1 : O_KVP2), okvs = g == 0 ? O_KVS0 : (g == 1 ? O_KVS1 : O_KVS2);
#pragma unroll
            for (int ai = 0; ai < 2; ++ai)
#pragma unroll
                for (int m = 0; m < 4; ++m) { const int row = row0 + ai * 128 + m * 16;
                    float* kvd = nullptr;
                    if (row < MP) { const int nn = row / TP, t = row % TP; if (t >= TP - W) kvd = out + okvp + ((size_t)nn * W + (t - (TP - W))) * 1024 + 512 + j * 64 + fq * 8; }
                    else kvd = out + okvs + (size_t)(row - MP) * 1024 + 512 + j * 64 + fq * 8;
                    bf16* dst = VA + (size_t)row * 1536 + hd * 64 + fq * 8;
#pragma unroll
                    for (int bj = 0; bj < 2; ++bj) { const pg8::f32x4 a0 = acc[ai][bj][m][0], a1 = acc[ai][bj][m][1];
                        v4u w; w.x = pk2(a0[0], a0[1]); w.y = pk2(a0[2], a0[3]); w.z = pk2(a1[0], a1[1]); w.w = pk2(a1[2], a1[3]);
                        if (prompt_unit) *(v4u*)(dst + bj * 32) = w;
                        if (kvd) { *(pg8::f32x4*)(kvd + bj * 32) = a0; *(pg8::f32x4*)(kvd + bj * 32 + 4) = a1; } } }
        } else if (pn >= 22 && pn < 24) {
            const int c0 = (pn - 22) * 256 + cw;
            float lb[2][2][4];
#pragma unroll
            for (int bj = 0; bj < 2; ++bj)
#pragma unroll
                for (int n = 0; n < 2; ++n) { const pg8::f32x4 t = *(const pg8::f32x4*)(LB + c0 + bj * 32 + n * 4);
#pragma unroll
                    for (int jj = 0; jj < 4; ++jj) lb[bj][n][jj] = t[jj]; }
#pragma unroll
            for (int ai = 0; ai < 2; ++ai)
#pragma unroll
                for (int m = 0; m < 4; ++m) { const int row = row0 + ai * 128 + m * 16;
#pragma unroll
                    for (int bj = 0; bj < 2; ++bj)
#pragma unroll
                        for (int n = 0; n < 2; ++n) { pg8::f32x4 o;
#pragma unroll
                            for (int jj = 0; jj < 4; ++jj) o[jj] = flog2(lb[bj][n][jj] + (1.f - lb[bj][n][jj]) * sigmoidf_(acc[ai][bj][m][n][jj]));
                            { typedef _Float16 h4_t __attribute__((ext_vector_type(4))); *(h4_t*)(LF + (size_t)row * 512 + c0 + bj * 32 + n * 4) = (h4_t){(_Float16)o[0], (_Float16)o[1], (_Float16)o[2], (_Float16)o[3]}; } } }
        } else {
            size_t woff; int ld, c0, act;
            if (pn < 20) { woff = WS_ZA; ld = 512; c0 = (pn - 18) * 256; act = 1; }
            else if (pn < 22) { woff = WS_QB; ld = 512; c0 = (pn - 20) * 256; act = 1; }
            else if (pn < 26) { woff = WS_IB; ld = 512; c0 = (pn - 24) * 256; act = 0; }
            else if (pn < 28) { woff = WS_ZB; ld = 512; c0 = (pn - 26) * 256; act = 1; }
            else if (pn < 32) { woff = WS_GA; ld = 1024; c0 = (pn - 28) * 256; act = 2; }
            else { woff = WS_GB; ld = 1024; c0 = (pn - 32) * 256; act = 2; }
            bf16* base = (bf16*)(ws + woff);
#pragma unroll
            for (int ai = 0; ai < 2; ++ai)
#pragma unroll
                for (int m = 0; m < 4; ++m) { const int row = row0 + ai * 128 + m * 16;
#pragma unroll
                    for (int bj = 0; bj < 2; ++bj) { float o[8];
#pragma unroll
                        for (int n = 0; n < 2; ++n)
#pragma unroll
                            for (int jj = 0; jj < 4; ++jj) { const float x = acc[ai][bj][m][n][jj]; const float sg = frcp(1.0f + fexp(-x)); o[n * 4 + jj] = act == 0 ? x : (act == 1 ? x * sg : sg); }
                        v4u w; w.x = pk2(o[0], o[1]); w.y = pk2(o[2], o[3]); w.z = pk2(o[4], o[5]); w.w = pk2(o[6], o[7]);
                        *(v4u*)(base + (size_t)row * ld + c0 + cw + bj * 32) = w; } }
        }
    }
};
__device__ __forceinline__ float gfl(float g) { return fmaxf(g, 1e-18f); }
struct EpiG2 {
    static constexpr bool PERM = true, AFTER_DRAIN = false, MIDK = true; const bf16* GA; const bf16* GB; bf16* MG;
    __device__ __forceinline__ void mid(pg8::f32x4 (&acc)[2][2][4][2], const pg8::Unit& u, int wr, int wc, int fr, int fq, int z) const {
        const int row0 = u.pm * 256 + wr * 64 + fr + z, lc0 = u.pn * 256 + wc * 64 + fq * 8;
#pragma unroll
        for (int ai = 0; ai < 2; ++ai) {
            v4u ga[4][2], gb[4][2];
#pragma unroll
            for (int m = 0; m < 4; ++m)
#pragma unroll
                for (int bj = 0; bj < 2; ++bj) { const size_t o = (size_t)(row0 + ai * 128 + m * 16) * D + lc0 + bj * 32; ga[m][bj] = *(const v4u*)(GA + o); gb[m][bj] = *(const v4u*)(GB + o); }
#pragma unroll
            for (int m = 0; m < 4; ++m)
#pragma unroll
                for (int bj = 0; bj < 2; ++bj) { const v4u a = ga[m][bj], b = gb[m][bj];
                    acc[ai][bj][m][0][0] *= bflo(a.x) * frcp(gfl(bflo(b.x))); acc[ai][bj][m][0][1] *= bfhi(a.x) * frcp(gfl(bfhi(b.x)));
                    acc[ai][bj][m][0][2] *= bflo(a.y) * frcp(gfl(bflo(b.y))); acc[ai][bj][m][0][3] *= bfhi(a.y) * frcp(gfl(bfhi(b.y)));
                    acc[ai][bj][m][1][0] *= bflo(a.z) * frcp(gfl(bflo(b.z))); acc[ai][bj][m][1][1] *= bfhi(a.z) * frcp(gfl(bfhi(b.z)));
                    acc[ai][bj][m][1][2] *= bflo(a.w) * frcp(gfl(bflo(b.w))); acc[ai][bj][m][1][3] *= bfhi(a.w) * frcp(gfl(bfhi(b.w))); }
            asm volatile("" ::: "memory");
        }
    }
    __device__ __forceinline__ void operator()(const pg8::f32x4 (&acc)[2][2][4][2], const pg8::Unit& u, int wr, int wc, int fr, int fq) const {
        const int row0 = u.pm * 256 + wr * 64 + fr, lc0 = u.pn * 256 + wc * 64 + fq * 8;
#pragma unroll
        for (int ai = 0; ai < 2; ++ai) {
            v4u gq[4][2];
#pragma unroll
            for (int m = 0; m < 4; ++m)
#pragma unroll
                for (int bj = 0; bj < 2; ++bj) gq[m][bj] = *(const v4u*)(GB + (size_t)(row0 + ai * 128 + m * 16) * D + lc0 + bj * 32);
#pragma unroll
            for (int m = 0; m < 4; ++m) { const int row = row0 + ai * 128 + m * 16;
#pragma unroll
                for (int bj = 0; bj < 2; ++bj) { const int c = lc0 + bj * 32; const v4u g = gq[m][bj];
                    const pg8::f32x4 a0 = acc[ai][bj][m][0], a1 = acc[ai][bj][m][1];
                    v4u w; w.x = pk2(gfl(bflo(g.x)) * a0[0], gfl(bfhi(g.x)) * a0[1]); w.y = pk2(gfl(bflo(g.y)) * a0[2], gfl(bfhi(g.y)) * a0[3]);
                    w.z = pk2(gfl(bflo(g.z)) * a1[0], gfl(bfhi(g.z)) * a1[1]); w.w = pk2(gfl(bflo(g.w)) * a1[2], gfl(bfhi(g.w)) * a1[3]);
                    *(v4u*)(MG + (size_t)row * D + c) = w; } }
        }
    }
};
struct EpiY {
    static constexpr bool PERM = true, AFTER_DRAIN = false; float* out; const float* xp; const float* xs; const float* ada;
    __device__ __forceinline__ void operator()(const pg8::f32x4 (&acc)[2][2][4][2], const pg8::Unit& u, int wr, int wc, int fr, int fq) const {
        const int row0 = u.pm * 256 + wr * 64 + fr, lc0 = u.pn * 256 + wc * 64 + fq * 8;
        if (u.pm < MP / 256) {
            const float* gr = ada + (size_t)((u.pm * 256) / TP) * 3072 + 2048;
            pg8::f32x4 gv[2][2];
#pragma unroll
            for (int bj = 0; bj < 2; ++bj)
#pragma unroll
                for (int n = 0; n < 2; ++n) gv[bj][n] = *(const pg8::f32x4*)(gr + lc0 + bj * 32 + n * 4);
#pragma unroll
            for (int ai = 0; ai < 2; ++ai) {
                pg8::f32x4 xv[4][2][2];
#pragma unroll
                for (int m = 0; m < 4; ++m) { const float* xr = xp + (size_t)(row0 + ai * 128 + m * 16) * D;
#pragma unroll
                    for (int bj = 0; bj < 2; ++bj)
#pragma unroll
                        for (int n = 0; n < 2; ++n) xv[m][bj][n] = *(const pg8::f32x4*)(xr + lc0 + bj * 32 + n * 4); }
#pragma unroll
                for (int m = 0; m < 4; ++m) { float* orow = out + O_YP + (size_t)(row0 + ai * 128 + m * 16) * D;
#pragma unroll
                    for (int bj = 0; bj < 2; ++bj)
#pragma unroll
                        for (int n = 0; n < 2; ++n) *(pg8::f32x4*)(orow + lc0 + bj * 32 + n * 4) = xv[m][bj][n] + gv[bj][n] * acc[ai][bj][m][n]; }
            }
            return;
        }
#pragma unroll
        for (int am = 0; am < 4; ++am) {
            const int ai = am >> 1;
            pg8::f32x4 xv[2][2][2], gv[2][2][2];
#pragma unroll
            for (int mm = 0; mm < 2; ++mm) { const int m = 2 * (am & 1) + mm, row = row0 + ai * 128 + m * 16; const int sq = seq_of_row(row);
                const float* xr = row < MP ? xp + (size_t)row * D : xs + (size_t)(row - MP) * D;
                const float* gr = ada + (size_t)sq * 3072 + 2048;
#pragma unroll
                for (int bj = 0; bj < 2; ++bj)
#pragma unroll
                    for (int n = 0; n < 2; ++n) { const int c = lc0 + bj * 32 + n * 4; gv[mm][bj][n] = *(const pg8::f32x4*)(gr + c); xv[mm][bj][n] = *(const pg8::f32x4*)(xr + c); } }
#pragma unroll
            for (int mm = 0; mm < 2; ++mm) { const int m = 2 * (am & 1) + mm, row = row0 + ai * 128 + m * 16;
                float* orow = out + (row < MP ? O_YP + (size_t)row * D : O_YS + (size_t)(row - MP) * D);
#pragma unroll
                for (int bj = 0; bj < 2; ++bj)
#pragma unroll
                    for (int n = 0; n < 2; ++n) { const int c = lc0 + bj * 32 + n * 4; *(pg8::f32x4*)(orow + c) = xv[mm][bj][n] + gv[mm][bj][n] * acc[ai][bj][m][n]; } }
        }
    }
};

__device__ __forceinline__ void p0_transpose_item(const float* W, int K, int N, bf16* WT, LAS float* scr, int item, int lane, int ldk = 0) {
    const int nblk = N / 32, kb = item / nblk, nb = item % nblk, k0 = 64 * kb, n0 = 32 * nb;
    float wv[32];
#pragma unroll
    for (int i = 0; i < 32; ++i) wv[i] = W[(size_t)(k0 + 2 * i + (lane >> 5)) * N + n0 + (lane & 31)];
#pragma unroll
    for (int i = 0; i < 32; ++i) scr[(2 * i + (lane >> 5)) * 33 + (lane & 31)] = wv[i];
    asm volatile("s_waitcnt lgkmcnt(0)" ::: "memory");
    const int c = lane & 7;
    const int pr0 = phys_row(n0);
#pragma unroll
    for (int j = 0; j < 4; ++j) { const int n = (lane >> 3) + 8 * j; const LAS float* s = scr + (8 * c) * 33 + n;
        v4u o; o.x = pk2(s[0 * 33], s[1 * 33]); o.y = pk2(s[2 * 33], s[3 * 33]); o.z = pk2(s[4 * 33], s[5 * 33]); o.w = pk2(s[6 * 33], s[7 * 33]);
        *(v4u*)(WT + (size_t)(pr0 + n) * (ldk ? ldk : K) + k0 + 8 * c) = o; }
    asm volatile("s_waitcnt lgkmcnt(0)" ::: "memory");
}


typedef short bf16x8 __attribute__((ext_vector_type(8)));
typedef short s16x4 __attribute__((ext_vector_type(4)));
typedef float f32x16 __attribute__((ext_vector_type(16)));
constexpr int AT_PITCH = 144;
constexpr int AT_KEYS = 384, AT_VOFF = AT_KEYS * AT_PITCH;
constexpr int N_ATT_UNITS = 3 * NP * 8 * 16;
template <int O0, int O1> __device__ __forceinline__ bf16x8 tr_read2(unsigned addr) {
    s16x4 a0, a1;
    asm volatile("ds_read_b64_tr_b16 %0, %2 offset:%3\n\tds_read_b64_tr_b16 %1, %2 offset:%4\n\ts_waitcnt lgkmcnt(0)" : "=&v"(a0), "=&v"(a1) : "v"(addr), "i"(O0), "i"(O1) : "memory");
    return (bf16x8){a0[0], a0[1], a0[2], a0[3], a1[0], a1[1], a1[2], a1[3]};
}
struct TrQuad { bf16x8 a, b, c, d; };
template <int A0, int A1, int B0, int B1, int C0, int C1, int D0, int D1> __device__ __forceinline__ TrQuad tr_read8(unsigned addr) {
    s16x4 r0, r1, r2, r3, r4, r5, r6, r7;
    asm volatile("ds_read_b64_tr_b16 %0, %8 offset:%9\n\tds_read_b64_tr_b16 %1, %8 offset:%10\n\tds_read_b64_tr_b16 %2, %8 offset:%11\n\tds_read_b64_tr_b16 %3, %8 offset:%12\n\t"
                 "ds_read_b64_tr_b16 %4, %8 offset:%13\n\tds_read_b64_tr_b16 %5, %8 offset:%14\n\tds_read_b64_tr_b16 %6, %8 offset:%15\n\tds_read_b64_tr_b16 %7, %8 offset:%16\n\ts_waitcnt lgkmcnt(0)"
                 : "=&v"(r0), "=&v"(r1), "=&v"(r2), "=&v"(r3), "=&v"(r4), "=&v"(r5), "=&v"(r6), "=&v"(r7)
                 : "v"(addr), "i"(A0), "i"(A1), "i"(B0), "i"(B1), "i"(C0), "i"(C1), "i"(D0), "i"(D1) : "memory");
    TrQuad q;
    q.a = (bf16x8){r0[0], r0[1], r0[2], r0[3], r1[0], r1[1], r1[2], r1[3]}; q.b = (bf16x8){r2[0], r2[1], r2[2], r2[3], r3[0], r3[1], r3[2], r3[3]};
    q.c = (bf16x8){r4[0], r4[1], r4[2], r4[3], r5[0], r5[1], r5[2], r5[3]}; q.d = (bf16x8){r6[0], r6[1], r6[2], r6[3], r7[0], r7[1], r7[2], r7[3]};
    return q;
}
__device__ __forceinline__ void attn_prompt_unit(LAS unsigned char* lds, int u, const bf16* QA, const bf16* KA, const bf16* VA, bf16* OG, float* LSE, int tid, int wave, int lane) {
    const int g = u >> 9, rem = u & 511, n = rem >> 7, j = (rem >> 4) & 7, rq = rem & 15;
    const int dsh = 2 * g, d = 1 << dsh, qsh = 4 - dsh;
    const int r = rq >> qsh, qb = rq & ((1 << qsh) - 1);
    const int hd = g * 8 + j, kbase = 256 * qb - 128;
    const size_t nrow0 = (size_t)n * TP + r;
    __syncthreads();
    v4u kld[6], vld[6];
#pragma unroll
    for (int i = 0; i < 6; ++i) {
        const int c = tid + 512 * i, key = c >> 3, ch = c & 7, pos = kbase + key;
        const size_t off = (nrow0 + (size_t)(pos >= 0 ? pos : 0) * d) * 1536 + hd * 64 + ch * 8;
        kld[i] = *(const v4u*)(KA + off); vld[i] = *(const v4u*)(VA + off);
    }
    const int ql = lane & 31, h = lane >> 5, q0base = 256 * qb + 32 * wave;
    const size_t qrow = nrow0 + (size_t)(q0base + ql) * d;
    bf16x8 qf[4];
#pragma unroll
    for (int s4 = 0; s4 < 4; ++s4) qf[s4] = *(const bf16x8*)(QA + qrow * 1536 + hd * 64 + 16 * s4 + 8 * h);
    __builtin_amdgcn_sched_barrier(0);
#pragma unroll
    for (int i = 0; i < 6; ++i) {
        const int c = tid + 512 * i, key = c >> 3, ch = c & 7, pos = kbase + key;
        v4u kv = kld[i], vv = vld[i];
        if (pos < 0) { kv = (v4u){0u, 0u, 0u, 0u}; vv = (v4u){0u, 0u, 0u, 0u}; }
        *(LAS v4u*)(lds + key * AT_PITCH + ch * 16) = kv; *(LAS v4u*)(lds + AT_VOFF + key * AT_PITCH + ch * 16) = vv;
    }
    __syncthreads();
    const int keyi = (ql & ~0xC) | ((ql & 4) << 1) | ((ql & 8) >> 1);
    f32x16 S[5];
#pragma unroll
    for (int kt = 0; kt < 5; ++kt) {
        const LAS unsigned char* kp = lds + (32 * wave + 32 * kt + keyi) * AT_PITCH + 16 * h;
        f32x16 acc;
#pragma unroll
        for (int e = 0; e < 16; ++e) acc[e] = 0.f;
#pragma unroll
        for (int s4 = 0; s4 < 4; ++s4) { const bf16x8 kf = *(const LAS bf16x8*)(kp + 32 * s4); acc = __builtin_amdgcn_mfma_f32_32x32x16_bf16(kf, qf[s4], acc, 0, 0, 0); }
        S[kt] = acc;
    }
    const float slope2d = exp2f(-8.0f * (float)(hd + 1) / 24.0f) * LOG2E * (float)d;
    const float qh = (float)(ql - 8 * h);
    float mx = -INFINITY;
#pragma unroll
    for (int kt = 0; kt < 5; ++kt) {
        const bool tile_ok = !(qb == 0 && wave + kt < 4);
#pragma unroll
        for (int e = 0; e < 16; ++e) {
            const int kk0 = (e & 3) + 4 * ((e >> 2) & 1) + 16 * (e >> 3);
            float v = S[kt][e] - slope2d * (qh + (float)(128 - 32 * kt - kk0));
            bool ok = tile_ok;
            if (kt == 0) ok = ok && ((float)kk0 >= qh);
            if (kt == 4) ok = ok && ((float)kk0 <= qh);
            v = ok ? v : -INFINITY;
            S[kt][e] = v; mx = fmaxf(mx, v);
        }
    }
    mx = fmaxf(mx, __shfl_xor(mx, 32));
    float l = 0.f;
#pragma unroll
    for (int kt = 0; kt < 5; ++kt)
#pragma unroll
        for (int e = 0; e < 16; ++e) { const float pv = fexp2(S[kt][e] - mx); S[kt][e] = pv; l += pv; }
    l += __shfl_xor(l, 32);
    const float inv = frcp(l);
    f32x16 O[2];
#pragma unroll
    for (int mt = 0; mt < 2; ++mt)
#pragma unroll
        for (int e = 0; e < 16; ++e) O[mt][e] = 0.f;
    const unsigned vb = (unsigned)(size_t)(lds + AT_VOFF) + (unsigned)(((lane & 15) >> 2) * AT_PITCH + (16 * ((lane >> 4) & 1) + 4 * (lane & 3)) * 2 + 8 * h * AT_PITCH + 32 * wave * AT_PITCH);
#pragma unroll
    for (int kt = 0; kt < 5; ++kt) {
        const TrQuad vq = tr_read8<0, 4 * AT_PITCH, 64, 4 * AT_PITCH + 64, 16 * AT_PITCH, 20 * AT_PITCH, 16 * AT_PITCH + 64, 20 * AT_PITCH + 64>(vb + 32 * kt * AT_PITCH);
#pragma unroll
        for (int sp = 0; sp < 2; ++sp) {
            v4u pw;
            pw.x = pk2(S[kt][8 * sp + 0] * inv, S[kt][8 * sp + 1] * inv); pw.y = pk2(S[kt][8 * sp + 2] * inv, S[kt][8 * sp + 3] * inv);
            pw.z = pk2(S[kt][8 * sp + 4] * inv, S[kt][8 * sp + 5] * inv); pw.w = pk2(S[kt][8 * sp + 6] * inv, S[kt][8 * sp + 7] * inv);
            const bf16x8 pf = __builtin_bit_cast(bf16x8, pw);
            O[0] = __builtin_amdgcn_mfma_f32_32x32x16_bf16(sp ? vq.c : vq.a, pf, O[0], 0, 0, 0);
            O[1] = __builtin_amdgcn_mfma_f32_32x32x16_bf16(sp ? vq.d : vq.b, pf, O[1], 0, 0, 0);
        }
    }
    const size_t orow = (size_t)g * M + qrow;
    bf16* op = OG + orow * 512 + j * 64 + 4 * h;
#pragma unroll
    for (int mt = 0; mt < 2; ++mt)
#pragma unroll
        for (int e4 = 0; e4 < 4; ++e4) { v2u w; w.x = pk2(O[mt][4 * e4 + 0], O[mt][4 * e4 + 1]); w.y = pk2(O[mt][4 * e4 + 2], O[mt][4 * e4 + 3]); *(v2u*)(op + 32 * mt + 8 * e4) = w; }
    if (h == 0) LSE[orow * 8 + j] = mx + flog2(l);
}

__device__ __forceinline__ float dpp_row16_sum(float v) {
    v += __builtin_bit_cast(float, __builtin_amdgcn_update_dpp(0, __builtin_bit_cast(int, v), 0xB1, 0xF, 0xF, true));
    v += __builtin_bit_cast(float, __builtin_amdgcn_update_dpp(0, __builtin_bit_cast(int, v), 0x4E, 0xF, 0xF, true));
    v += __builtin_bit_cast(float, __builtin_amdgcn_update_dpp(0, __builtin_bit_cast(int, v), 0x141, 0xF, 0xF, true));
    v += __builtin_bit_cast(float, __builtin_amdgcn_update_dpp(0, __builtin_bit_cast(int, v), 0x140, 0xF, 0xF, true));
    return v;
}
constexpr int N_SAMP_ITEMS = NS * 8 * (1 + 4 + 8);
template <int G> __device__ __forceinline__ void attn_sample_item(LAS float* wl, int item, const bf16* QA, const float* cacheg, const float* kvs_out, bf16* OG, float* LSE, int lane) {
    constexpr int d = G == 0 ? 1 : (G == 1 ? 4 : 16), NQ = G == 0 ? 8 : (G == 1 ? 2 : 1), wb = G == 0 ? 128 : (G == 1 ? 512 : 2048), U = 128 + NQ, NR = d < 8 ? d : 8;
    constexpr int NIT = (U + 3) / 4;
    const int rho = item % NR, nj = item / NR, j = nj & 7, n = nj >> 3;
    const int ks = lane >> 4, c = lane & 15;
    const float* cg = cacheg + (size_t)n * wb * 1024 + j * 64 + 4 * c;
    const float* kn = kvs_out + (size_t)n * TS * 1024 + j * 64 + 4 * c;
    const float slope2d = exp2f(-8.0f * (float)(G * 8 + j + 1) / 24.0f) * LOG2E * (float)d;
    float4 qf[NQ];
    v2u qraw[NQ];
#pragma unroll
    for (int qi = 0; qi < NQ; ++qi) qraw[qi] = *(const v2u*)(QA + (size_t)(MP + n * TS + rho + d * qi) * 1536 + (G * 8 + j) * 64 + 4 * c);
    __builtin_amdgcn_sched_barrier(0);
#pragma unroll
    for (int qi = 0; qi < NQ; ++qi) qf[qi] = make_float4(bflo(qraw[qi].x), bfhi(qraw[qi].x), bflo(qraw[qi].y), bfhi(qraw[qi].y));
    LAS float* sc = wl;
    LAS float* pT = wl + 8 * 136;
    constexpr int NB = (NIT + 7) / 8;
    constexpr int RB = NQ == 1 ? 6 : 5, NBP = NQ == 1 ? 6 : 7;
    static_assert(NB == 5 && RB * NBP >= NIT, "sample attention batches");
    float4 ra[RB], rb[RB];
    const float* cbase = cg + (size_t)(rho + d * ks) * 1024;
    const float* nbase = kn + (size_t)(rho + d * ks) * 1024;
#define SA_LOAD(buf, b_, voff) do { _Pragma("unroll") for (int i = 0; i < RB; ++i) { \
        if (RB * (b_) + i < 32) buf[i] = *(const float4*)(cbase + (size_t)((4 * (RB * (b_) + i)) * d) * 1024 + (voff)); \
        else buf[i] = (4 * (RB * (b_) + i - 32) + ks < NQ) ? *(const float4*)(nbase + (size_t)(4 * (RB * (b_) + i - 32) * d) * 1024 + (voff)) : make_float4(0.f, 0.f, 0.f, 0.f); } \
        __builtin_amdgcn_sched_barrier(0); } while (0)
#define SA_SCORE(buf, b_) do { _Pragma("unroll") for (int i = 0; i < RB; ++i) { int u = 4 * ((b_) * RB + i) + ks; \
        asm volatile("" : "+v"(u));     \
        const float fu = (float)(u - 128); \
        _Pragma("unroll") for (int qi = 0; qi < NQ; ++qi) { \
            float dp = qf[qi].x * buf[i].x + qf[qi].y * buf[i].y + qf[qi].z * buf[i].z + qf[qi].w * buf[i].w; \
            dp = dpp_row16_sum(dp); \
            const bool ok = (u >= qi) && (u <= qi + 128); \
            const float v = ok ? fmaf(slope2d, fu - (float)qi, dp) : -INFINITY; \
            if (c == qi && u < 136) sc[qi * 136 + u] = v; } __builtin_amdgcn_sched_barrier(0); } } while (0)
#define SA_PV(buf, b_) do { _Pragma("unroll") for (int i = 0; i < RB; ++i) { const int u = 4 * ((b_) * RB + i) + ks; \
        _Pragma("unroll") for (int qi = 0; qi < NQ; ++qi) { const float pq = u < U ? pT[u * NQ + qi] : 0.f; \
            o[qi].x = fmaf(pq, buf[i].x, o[qi].x); o[qi].y = fmaf(pq, buf[i].y, o[qi].y); o[qi].z = fmaf(pq, buf[i].z, o[qi].z); o[qi].w = fmaf(pq, buf[i].w, o[qi].w); } \
        __builtin_amdgcn_sched_barrier(0); } } while (0)
    if constexpr (NQ == 1) {
    SA_LOAD(ra, 0, 0);
    SA_LOAD(rb, 1, 0); SA_SCORE(ra, 0);
    SA_LOAD(ra, 2, 0); SA_SCORE(rb, 1);
    SA_LOAD(rb, 3, 0); SA_SCORE(ra, 2);
    SA_LOAD(ra, 4, 0); SA_SCORE(rb, 3);
    SA_LOAD(rb, 5, 0); SA_SCORE(ra, 4);
    SA_LOAD(ra, 0, 512); SA_SCORE(rb, 5);
    } else if constexpr (NQ == 2) {
    SA_LOAD(ra, 0, 0);
    SA_LOAD(rb, 1, 0); SA_SCORE(ra, 0);
    SA_LOAD(ra, 2, 0); SA_SCORE(rb, 1);
    SA_LOAD(rb, 3, 0); SA_SCORE(ra, 2);
    SA_LOAD(ra, 4, 0); SA_SCORE(rb, 3);
    SA_LOAD(rb, 5, 0); SA_SCORE(ra, 4);
    SA_LOAD(ra, 6, 0); SA_SCORE(rb, 5);
    SA_LOAD(rb, 0, 512); SA_SCORE(ra, 6);
    } else {
#pragma unroll 1
    for (int b = 0; b < NB; ++b) {
        float4 kr[8];
#pragma unroll
        for (int i = 0; i < 8; ++i) { const int u = 4 * (b * 8 + i) + ks; const int idx = rho + d * u;
            const float* p = idx < wb ? cg + (size_t)idx * 1024 : kn + (size_t)(idx - wb) * 1024;
            kr[i] = u < U ? *(const float4*)p : make_float4(0.f, 0.f, 0.f, 0.f); }
#pragma unroll
        for (int i = 0; i < 8; ++i) { const int u = 4 * (b * 8 + i) + ks; float wsel = -INFINITY;
#pragma unroll
            for (int qi = 0; qi < NQ; ++qi) {
                float dp = qf[qi].x * kr[i].x + qf[qi].y * kr[i].y + qf[qi].z * kr[i].z + qf[qi].w * kr[i].w;
                dp = dpp_row16_sum(dp);
                const bool ok = (u >= qi) && (u <= qi + 128);
                const float v = ok ? dp - slope2d * (float)(128 + qi - u) : -INFINITY;
                wsel = (c == qi) ? v : wsel;
            }
            if (c < NQ && u < 136) sc[c * 136 + u] = wsel;
            __builtin_amdgcn_sched_barrier(0);
        }
    }
    }
    __builtin_amdgcn_wave_barrier();
#pragma unroll
    for (int qi = 0; qi < NQ; ++qi) {
        const float s0 = sc[qi * 136 + lane], s1 = sc[qi * 136 + 64 + lane], s2 = (128 + lane < U) ? sc[qi * 136 + 128 + lane] : -INFINITY;
        const float m = wave_max(fmaxf(fmaxf(s0, s1), s2));
        const float p0 = fexp2(s0 - m), p1 = fexp2(s1 - m), p2 = fexp2(s2 - m);
        const float l = wave_sum(p0 + p1 + p2), inv = frcp(l);
        pT[lane * NQ + qi] = p0 * inv; pT[(64 + lane) * NQ + qi] = p1 * inv; if (128 + lane < U) pT[(128 + lane) * NQ + qi] = p2 * inv;
        if (lane == 0) LSE[((size_t)G * M + MP + n * TS + rho + d * qi) * 8 + j] = m + flog2(l);
    }
    __builtin_amdgcn_wave_barrier();
    __builtin_amdgcn_sched_barrier(0);
    float4 o[NQ];
#pragma unroll
    for (int qi = 0; qi < NQ; ++qi) o[qi] = make_float4(0.f, 0.f, 0.f, 0.f);
    if constexpr (NQ == 1) {
    SA_LOAD(rb, 1, 512); SA_PV(ra, 0);
    SA_LOAD(ra, 2, 512); SA_PV(rb, 1);
    SA_LOAD(rb, 3, 512); SA_PV(ra, 2);
    SA_LOAD(ra, 4, 512); SA_PV(rb, 3);
    SA_LOAD(rb, 5, 512); SA_PV(ra, 4);
    SA_PV(rb, 5);
    } else if constexpr (NQ == 2) {
    SA_LOAD(ra, 1, 512); SA_PV(rb, 0);
    SA_LOAD(rb, 2, 512); SA_PV(ra, 1);
    SA_LOAD(ra, 3, 512); SA_PV(rb, 2);
    SA_LOAD(rb, 4, 512); SA_PV(ra, 3);
    SA_LOAD(ra, 5, 512); SA_PV(rb, 4);
    SA_LOAD(rb, 6, 512); SA_PV(ra, 5);
    SA_PV(rb, 6);
    } else {
#pragma unroll 1
    for (int b = 0; b < NB; ++b) {
        float4 vr[8];
#pragma unroll
        for (int i = 0; i < 8; ++i) { const int u = 4 * (b * 8 + i) + ks; const int idx = rho + d * u;
            const float* p = idx < wb ? cg + (size_t)idx * 1024 : kn + (size_t)(idx - wb) * 1024;
            vr[i] = u < U ? *(const float4*)(p + 512) : make_float4(0.f, 0.f, 0.f, 0.f); }
#pragma unroll
        for (int i = 0; i < 8; ++i) { const int u = 4 * (b * 8 + i) + ks;
#pragma unroll
            for (int qi = 0; qi < NQ; ++qi) { const float pq = u < U ? pT[u * NQ + qi] : 0.f;
                o[qi].x = fmaf(pq, vr[i].x, o[qi].x); o[qi].y = fmaf(pq, vr[i].y, o[qi].y); o[qi].z = fmaf(pq, vr[i].z, o[qi].z); o[qi].w = fmaf(pq, vr[i].w, o[qi].w); }
        }
    }
    }
#undef SA_LOAD
#undef SA_SCORE
#undef SA_PV
#pragma unroll
    for (int qi = 0; qi < NQ; ++qi) {
        float4 t = o[qi];
        t.x += __shfl_xor(t.x, 16); t.y += __shfl_xor(t.y, 16); t.z += __shfl_xor(t.z, 16); t.w += __shfl_xor(t.w, 16);
        t.x += __shfl_xor(t.x, 32); t.y += __shfl_xor(t.y, 32); t.z += __shfl_xor(t.z, 32); t.w += __shfl_xor(t.w, 32);
        if (ks == 0) { v2u w; w.x = pk2(t.x, t.y); w.y = pk2(t.z, t.w); *(v2u*)(OG + ((size_t)G * M + MP + n * TS + rho + d * qi) * 512 + j * 64 + 4 * c) = w; }
    }
    __builtin_amdgcn_wave_barrier();
}

constexpr int HG_P = 272;
constexpr int N_HG_ITEMS = NP * 4 * 64;
constexpr int HC_QI = 2048, HC_QD = HC_QI + 64 * HG_P, HC_QO = HC_QD + 64 * HG_P, HC_KD = HC_QO + 32 * HG_P, HC_KO = HC_KD + 64 * HG_P, HC_VI = HC_KO + 32 * HG_P,
              HC_SI = HC_VI + 64 * HG_P, HC_SS = HC_SI + 128 * HG_P, HC_END = HC_SS + 1024;
static_assert(HC_END <= RING_BYTES, "HGRN phase C LDS map");
constexpr int HA_KT = 2048, HA_VI = HA_KT + 128 * 144;
__device__ __forceinline__ void hg_scan(LAS unsigned char* lds, int f, int seg, const float (&lf)[16], float (&b)[16], float& B15, float& B31, float& B47, float& B63) {
    LAS float* TOT = (LAS float*)lds;
    float run = 0.f;
#pragma unroll
    for (int tt = 0; tt < 16; ++tt) { run += lf[tt]; b[tt] = run; }
    TOT[seg * 128 + f] = run;
    __syncthreads();
    const float t0 = TOT[f], t1 = TOT[128 + f], t2 = TOT[256 + f], t3 = TOT[384 + f];
    B15 = t0; B31 = t0 + t1; B47 = B31 + t2; B63 = B47 + t3;
    const float pre = seg == 0 ? 0.f : (seg == 1 ? B15 : (seg == 2 ? B31 : B47));
#pragma unroll
    for (int tt = 0; tt < 16; ++tt) b[tt] += pre;
}
__device__ __forceinline__ void hg_prep(LAS unsigned char* lds, const _Float16* LF, size_t row0, int col, int f, int seg, float (&lf)[16], float (&b)[16], float& B15, float& B31, float& B47, float& B63) {
#pragma unroll
    for (int tt = 0; tt < 16; ++tt) lf[tt] = (float)LF[(row0 + 16 * seg + tt) * 512 + col];
    hg_scan(lds, f, seg, lf, b, B15, B31, B47, B63);
}
__device__ __forceinline__ bf16x8 tr_pair(unsigned addr) { return tr_read2<0, 4 * HG_P>(addr); }
struct HaPre { float lf[16]; v4u vch[2]; };
__device__ __forceinline__ void hgrn_phaseA_prefetch(HaPre& P, int item, const _Float16* LF, const bf16* IB, int tid) {
    const int nh = item >> 6, c = item & 63, n = nh >> 2, h = nh & 3;
    const size_t row0 = (size_t)n * TP + c * 64;
    const int f = tid & 127, seg = tid >> 7, col = h * 128 + f;
#pragma unroll
    for (int tt = 0; tt < 16; ++tt) P.lf[tt] = (float)LF[(row0 + 16 * seg + tt) * 512 + col];
#pragma unroll
    for (int k = 0; k < 2; ++k) { const int ci = tid + 512 * k, sr = ci >> 4, ch = ci & 15; P.vch[k] = *(const v4u*)(IB + (row0 + sr) * 512 + h * 128 + ch * 8); }
}
__device__ __forceinline__ void hgrn_phaseA_item(LAS unsigned char* lds, int item, HaPre& P, bool has_next, int item_next, const _Float16* LF, const bf16* IB, float* DS, float* DEC, int tid, int wave, int lane) {
    const int f = tid & 127, seg = tid >> 7;
    __syncthreads();
    float lf[16], b[16], B15, B31, B47, B63;
#pragma unroll
    for (int tt = 0; tt < 16; ++tt) lf[tt] = P.lf[tt];
    v4u vch[2]; vch[0] = P.vch[0]; vch[1] = P.vch[1];
    hg_scan(lds, f, seg, lf, b, B15, B31, B47, B63);
    if (has_next) hgrn_phaseA_prefetch(P, item_next, LF, IB, tid);
    {
        float kk[16];
#pragma unroll
        for (int tt = 0; tt < 16; ++tt) kk[tt] = (1.0f - fexp2(lf[tt])) * fexp2(B63 - b[tt]);
        v4u w0, w1;
        w0.x = pk2(kk[0], kk[1]); w0.y = pk2(kk[2], kk[3]); w0.z = pk2(kk[4], kk[5]); w0.w = pk2(kk[6], kk[7]);
        w1.x = pk2(kk[8], kk[9]); w1.y = pk2(kk[10], kk[11]); w1.z = pk2(kk[12], kk[13]); w1.w = pk2(kk[14], kk[15]);
        *(LAS v4u*)(lds + HA_KT + f * 144 + seg * 32) = w0; *(LAS v4u*)(lds + HA_KT + f * 144 + seg * 32 + 16) = w1;
    }
#pragma unroll
    for (int k = 0; k < 2; ++k) { const int ci = tid + 512 * k, sr = ci >> 4, ch = ci & 15; *(LAS v4u*)(lds + HA_VI + sr * HG_P + ch * 16) = vch[k]; }
    if (seg == 0) DEC[(size_t)item * 128 + f] = fexp2(B63);
    __syncthreads();
    const int fm = wave >> 1, hh = lane >> 5, l31 = lane & 31;
    const unsigned vlane = (unsigned)(size_t)(lds + HA_VI) + (unsigned)(((lane & 15) >> 2) * HG_P + (16 * ((lane >> 4) & 1) + 4 * (lane & 3)) * 2 + 8 * hh * HG_P);
#pragma unroll
    for (int im2 = 0; im2 < 2; ++im2) {
        const int im = 2 * (wave & 1) + im2;
        f32x16 acc;
#pragma unroll
        for (int e = 0; e < 16; ++e) acc[e] = 0.f;
        const TrQuad vq = tr_read8<0, 4 * HG_P, 16 * HG_P, 20 * HG_P, 32 * HG_P, 36 * HG_P, 48 * HG_P, 52 * HG_P>(vlane + 64 * im);
#pragma unroll
        for (int ks = 0; ks < 4; ++ks) {
            const bf16x8 A = *(const LAS bf16x8*)(lds + HA_KT + (32 * fm + l31) * 144 + (16 * ks + 8 * hh) * 2);
            acc = __builtin_amdgcn_mfma_f32_32x32x16_bf16(A, ks == 0 ? vq.a : (ks == 1 ? vq.b : (ks == 2 ? vq.c : vq.d)), acc, 0, 0, 0);
        }
#pragma unroll
        for (int e4 = 0; e4 < 4; ++e4)
            { v2u w; w.x = pk2(acc[4 * e4 + 0], acc[4 * e4 + 1]); w.y = pk2(acc[4 * e4 + 2], acc[4 * e4 + 3]);
              *(v2u*)((bf16*)DS + ((size_t)item * 128 + 32 * im + l31) * 128 + 32 * fm + 8 * e4 + 4 * hh) = w; }
    }
}
struct HcPre { float lf[16]; unsigned short qraw[16]; v4u vch[2], sch[4]; };
__device__ __forceinline__ void hgrn_phaseC_prefetch(HcPre& P, int item, const _Float16* LF, const bf16* QB, const bf16* IB, const bf16* SB, int tid) {
    const int nh = item >> 6, c = item & 63, n = nh >> 2, h = nh & 3;
    const size_t row0 = (size_t)n * TP + c * 64;
    const int f = tid & 127, seg = tid >> 7, col = h * 128 + f;
#pragma unroll
    for (int tt = 0; tt < 16; ++tt) { P.lf[tt] = (float)LF[(row0 + 16 * seg + tt) * 512 + col]; P.qraw[tt] = QB[(row0 + 16 * seg + tt) * 512 + col]; }
#pragma unroll
    for (int k = 0; k < 2; ++k) { const int ci = tid + 512 * k, sr = ci >> 4, ch = ci & 15; P.vch[k] = *(const v4u*)(IB + (row0 + sr) * 512 + h * 128 + ch * 8); }
    if (c > 0) {
#pragma unroll
        for (int k = 0; k < 4; ++k) { const int ci = tid + 512 * k, fr = ci >> 4, ch = ci & 15; P.sch[k] = *(const v4u*)(SB + ((size_t)item * 128 + fr) * 128 + ch * 8); }
    }
}
__device__ __forceinline__ void hgrn_phaseC_item(LAS unsigned char* lds, int item, HcPre& P, bool has_next, int item_next, const _Float16* LF, const bf16* QB, const bf16* IB, const bf16* ZB, const bf16* SB,
                                                 const float* o_gain, bf16* OB, int tid, int wave, int lane) {
    const int nh = item >> 6, c = item & 63, n = nh >> 2, h = nh & 3;
    const size_t row0 = (size_t)n * TP + c * 64;
    const int f = tid & 127, seg = tid >> 7;
    __syncthreads();
    float b[16], B15, B31, B47, B63;
    hg_scan(lds, f, seg, P.lf, b, B15, B31, B47, B63);
    {
        const int blk = seg >> 1; const float mid = blk ? B47 : B15;
#pragma unroll
        for (int tt = 0; tt < 16; ++tt) {
            const int t = 16 * seg + tt;
            const float qv = bf2f(P.qraw[tt]), kf = 1.0f - fexp2(P.lf[tt]);
            *(LAS bf16*)(lds + HC_QI + t * HG_P + f * 2) = (bf16)f2bf(qv * fexp2(b[tt]));
            *(LAS bf16*)(lds + HC_QD + t * HG_P + f * 2) = (bf16)f2bf(qv * fexp2(b[tt] - mid));
            *(LAS bf16*)(lds + HC_KD + t * HG_P + f * 2) = (bf16)f2bf(kf * fexp2(mid - b[tt]));
            if (blk) *(LAS bf16*)(lds + HC_QO + (t - 32) * HG_P + f * 2) = (bf16)f2bf(qv * fexp2(b[tt] - B31));
            else     *(LAS bf16*)(lds + HC_KO + t * HG_P + f * 2) = (bf16)f2bf(kf * fexp2(B31 - b[tt]));
        }
    }
#pragma unroll
    for (int k = 0; k < 2; ++k) { const int ci = tid + 512 * k, sr = ci >> 4, ch = ci & 15; *(LAS v4u*)(lds + HC_VI + sr * HG_P + ch * 16) = P.vch[k]; }
    if (c > 0) {
#pragma unroll
        for (int k = 0; k < 4; ++k) { const int ci = tid + 512 * k, fr = ci >> 4, ch = ci & 15; *(LAS v4u*)(lds + HC_SI + fr * HG_P + ch * 16) = P.sch[k]; }
    }
    if (has_next) hgrn_phaseC_prefetch(P, item_next, LF, QB, IB, SB, tid);
    __syncthreads();
    const int tt2 = wave & 1, im = wave >> 1, hh = lane >> 5, l31 = lane & 31;
    const int keyi = (l31 & ~0xC) | ((l31 & 4) << 1) | ((l31 & 8) >> 1);
    v2u zq[4]; f32x4 gq[4];
#pragma unroll
    for (int e4 = 0; e4 < 4; ++e4) { const int i0 = 32 * im + 8 * e4 + 4 * hh; gq[e4] = *(const f32x4*)(o_gain + i0); zq[e4] = *(const v2u*)(ZB + (row0 + 32 * tt2 + l31) * 512 + h * 128 + i0); }
    f32x16 Xd, Xo;
#pragma unroll
    for (int e = 0; e < 16; ++e) { Xd[e] = 0.f; Xo[e] = 0.f; }
#pragma unroll
    for (int kf = 0; kf < 8; ++kf) {
        const bf16x8 A = *(const LAS bf16x8*)(lds + HC_KD + (32 * tt2 + keyi) * HG_P + (16 * kf + 8 * hh) * 2);
        const bf16x8 B = *(const LAS bf16x8*)(lds + HC_QD + (32 * tt2 + l31) * HG_P + (16 * kf + 8 * hh) * 2);
        Xd = __builtin_amdgcn_mfma_f32_32x32x16_bf16(A, B, Xd, 0, 0, 0);
    }
#pragma unroll
    for (int e = 0; e < 16; ++e) { const int sl = (e & 3) + 4 * ((e >> 2) & 1) + 16 * (e >> 3) + 8 * hh; Xd[e] = (sl <= l31) ? Xd[e] : 0.f; }
    if (tt2 == 1) {
#pragma unroll
        for (int kf = 0; kf < 8; ++kf) {
            const bf16x8 A = *(const LAS bf16x8*)(lds + HC_KO + keyi * HG_P + (16 * kf + 8 * hh) * 2);
            const bf16x8 B = *(const LAS bf16x8*)(lds + HC_QO + l31 * HG_P + (16 * kf + 8 * hh) * 2);
            Xo = __builtin_amdgcn_mfma_f32_32x32x16_bf16(A, B, Xo, 0, 0, 0);
        }
    }
    f32x16 acc;
#pragma unroll
    for (int e = 0; e < 16; ++e) acc[e] = 0.f;
    const unsigned lanep = (unsigned)(((lane & 15) >> 2) * HG_P + (16 * ((lane >> 4) & 1) + 4 * (lane & 3)) * 2 + 8 * hh * HG_P + 64 * im);
    const unsigned vlane = (unsigned)(size_t)(lds + HC_VI) + lanep;
    {
        const TrQuad vq = tr_read8<0, 4 * HG_P, 16 * HG_P, 20 * HG_P, 32 * HG_P, 36 * HG_P, 48 * HG_P, 52 * HG_P>(vlane);
        if (tt2 == 1) {
#pragma unroll
            for (int ks = 0; ks < 2; ++ks) {
                v4u pw; pw.x = pk2(Xo[8 * ks + 0], Xo[8 * ks + 1]); pw.y = pk2(Xo[8 * ks + 2], Xo[8 * ks + 3]); pw.z = pk2(Xo[8 * ks + 4], Xo[8 * ks + 5]); pw.w = pk2(Xo[8 * ks + 6], Xo[8 * ks + 7]);
                acc = __builtin_amdgcn_mfma_f32_32x32x16_bf16(ks ? vq.b : vq.a, __builtin_bit_cast(bf16x8, pw), acc, 0, 0, 0);
            }
        }
#pragma unroll
        for (int ks = 0; ks < 2; ++ks) {
            v4u pw; pw.x = pk2(Xd[8 * ks + 0], Xd[8 * ks + 1]); pw.y = pk2(Xd[8 * ks + 2], Xd[8 * ks + 3]); pw.z = pk2(Xd[8 * ks + 4], Xd[8 * ks + 5]); pw.w = pk2(Xd[8 * ks + 6], Xd[8 * ks + 7]);
            const bf16x8 A = tt2 ? (ks ? vq.d : vq.c) : (ks ? vq.b : vq.a);
            acc = __builtin_amdgcn_mfma_f32_32x32x16_bf16(A, __builtin_bit_cast(bf16x8, pw), acc, 0, 0, 0);
        }
    }
    if (c > 0) {
#pragma unroll
        for (int kf = 0; kf < 8; ++kf) {
            const bf16x8 A = *(const LAS bf16x8*)(lds + HC_SI + (32 * im + l31) * HG_P + (16 * kf + 8 * hh) * 2);
            const bf16x8 B = *(const LAS bf16x8*)(lds + HC_QI + (32 * tt2 + l31) * HG_P + (16 * kf + 8 * hh) * 2);
            acc = __builtin_amdgcn_mfma_f32_32x32x16_bf16(A, B, acc, 0, 0, 0);
        }
    }
    float ss = 0.f;
#pragma unroll
    for (int e = 0; e < 16; ++e) ss += acc[e] * acc[e];
    ss += __shfl_xor(ss, 32);
    LAS float* SS = (LAS float*)(lds + HC_SS);
    if (hh == 0) SS[im * 64 + 32 * tt2 + l31] = ss;
    __syncthreads();
    const int t = 32 * tt2 + l31;
    const float tot = (SS[t] + SS[64 + t]) + (SS[128 + t] + SS[192 + t]);
    const float rstd = frsq(tot * (1.0f / 128.f) + EPS);
#pragma unroll
    for (int e4 = 0; e4 < 4; ++e4) {
        const int i0 = 32 * im + 8 * e4 + 4 * hh;
        const f32x4 gn = gq[e4];
        const v2u z = zq[e4];
        v2u w; w.x = pk2(acc[4 * e4 + 0] * rstd * gn[0] * bflo(z.x), acc[4 * e4 + 1] * rstd * gn[1] * bfhi(z.x));
        w.y = pk2(acc[4 * e4 + 2] * rstd * gn[2] * bflo(z.y), acc[4 * e4 + 3] * rstd * gn[3] * bfhi(z.y));
        *(v2u*)(OB + (row0 + t) * 1024 + h * 128 + i0) = w;
    }
}
__device__ __forceinline__ void hgrn_sample_item(LAS float* wl, int item, const _Float16* LF, const bf16* QB, const bf16* IB, const float* state_in, float* OBR, float* out_state, int lane) {
    const int half = item & 1, nh = item >> 1, h = nh & 3, n = nh >> 2;
    const int cq = lane & 15, fq = lane >> 4;
    LAS float* FV = wl; LAS float* QV = wl + 1024;
    const size_t rowb = (size_t)MP + n * TS;
    {
        _Float16 lfr[2 * TS]; bf16 qbr[2 * TS];
#pragma unroll
        for (int t = 0; t < TS; ++t)
#pragma unroll
            for (int k = 0; k < 2; ++k) { const int f = lane + 64 * k; lfr[2 * t + k] = LF[(rowb + t) * 512 + h * 128 + f]; qbr[2 * t + k] = QB[(rowb + t) * 512 + h * 128 + f]; }
        __builtin_amdgcn_sched_barrier(0);
#pragma unroll
        for (int t = 0; t < TS; ++t)
#pragma unroll
            for (int k = 0; k < 2; ++k) { const int f = lane + 64 * k; FV[t * 128 + f] = fexp2((float)lfr[2 * t + k]); QV[t * 128 + f] = bf2f(qbr[2 * t + k]); }
    }
    f32x4 S[32];
    const float* s0 = state_in + ((size_t)nh * 128 + 32 * fq) * 128 + 64 * half + 4 * cq;
#pragma unroll
    for (int ff = 0; ff < 32; ++ff) S[ff] = *(const f32x4*)(s0 + (size_t)ff * 128);
    __builtin_amdgcn_wave_barrier();
    v2u vnext = *(const v2u*)(IB + rowb * 512 + h * 128 + 64 * half + 4 * cq);
#pragma unroll 1
    for (int t = 0; t < TS; ++t) {
        const v2u vw = vnext;
        if (t + 1 < TS) vnext = *(const v2u*)(IB + (rowb + t + 1) * 512 + h * 128 + 64 * half + 4 * cq);
        const f32x4 v = (f32x4){bflo(vw.x), bfhi(vw.x), bflo(vw.y), bfhi(vw.y)};
        f32x4 o = (f32x4){0.f, 0.f, 0.f, 0.f};
#pragma unroll
        for (int j = 0; j < 8; ++j) {
            const f32x4 F = *(const LAS f32x4*)(FV + t * 128 + 32 * fq + 4 * j), Q = *(const LAS f32x4*)(QV + t * 128 + 32 * fq + 4 * j);
#pragma unroll
            for (int e = 0; e < 4; ++e) { S[4 * j + e] = S[4 * j + e] * F[e] + v * (1.0f - F[e]); o = o + S[4 * j + e] * Q[e]; }
        }
#pragma unroll
        for (int e = 0; e < 4; ++e) { o[e] += __shfl_xor(o[e], 16); o[e] += __shfl_xor(o[e], 32); }
        if (fq == 0) *(f32x4*)(OBR + (rowb + t) * 512 + h * 128 + 64 * half + 4 * cq) = o;
    }
    float* so = out_state + ((size_t)nh * 128 + 32 * fq) * 128 + 64 * half + 4 * cq;
#pragma unroll
    for (int ff = 0; ff < 32; ++ff) *(f32x4*)(so + (size_t)ff * 128) = S[ff];
    __builtin_amdgcn_wave_barrier();
}


#define DPPF(x, ctrl) __builtin_bit_cast(float, __builtin_amdgcn_update_dpp(0, __builtin_bit_cast(int, (x)), (ctrl), 0xF, 0xF, true))
template <int NQ> __device__ __forceinline__ float row16_reduce_t(const float (&v)[4 * NQ], int c) {
    const bool b0 = c & 1, b1 = c & 2;
    float s[2 * NQ];
#pragma unroll
    for (int k = 0; k < 2 * NQ; ++k) { const float keep = b0 ? v[2 * k + 1] : v[2 * k], send = b0 ? v[2 * k] : v[2 * k + 1]; s[k] = keep + DPPF(send, 0xB1); }
    float t[NQ];
#pragma unroll
    for (int k = 0; k < NQ; ++k) { const float keep = b1 ? s[2 * k + 1] : s[2 * k], send = b1 ? s[2 * k] : s[2 * k + 1]; t[k] = keep + DPPF(send, 0x4E); }
#pragma unroll
    for (int k = 0; k < NQ; ++k) { t[k] += DPPF(t[k], 0x128); t[k] += DPPF(t[k], 0x124); }
    if (NQ == 1) return t[0];
    return (c & 4) ? t[NQ - 1] : t[0];
}

constexpr int S4_RING3 = 2560;
constexpr int S4_RING = 4608;
template <int G> __device__ __forceinline__ void attn_sample_item4(LAS unsigned char* wlb, int n, int jh, int rho, const bf16* QA, const float* cacheg, const float* kvs_out, bf16* OG, float* LSE, int lane) {
    constexpr int d = G == 1 ? 4 : 16, NQ = G == 1 ? 2 : 1, wb = G == 1 ? 512 : 2048, U = 128 + NQ;
    constexpr int UG = (U + 3) / 4, NG = 2 * UG;
    static_assert(G == 2, "whole-row form, three-group ring: group 2 (group 1 runs as attn_sample_item4h)"); static_assert(4 * NQ * 136 * 4 <= S4_RING3 && S4_RING3 + 12 * 1024 <= 16384, "wave LDS region");
    const int jl = lane >> 4, c = lane & 15, hd = G * 8 + 4 * jh + jl;
    const float* cbase = cacheg + ((size_t)n * wb + rho) * 1024 + (4 * jh + jl) * 64 + 4 * c;
    const float* nbase = kvs_out + ((size_t)n * TS + rho) * 1024 + (4 * jh + jl) * 64 + 4 * c;
    const float slope2d = exp2f(-8.0f * (float)(hd + 1) / 24.0f) * LOG2E * (float)d;
    float4 qf[NQ];
#pragma unroll
    for (int qi = 0; qi < NQ; ++qi) { const v2u w = *(const v2u*)(QA + (size_t)(MP + n * TS + rho + d * qi) * 1536 + hd * 64 + 4 * c);
        qf[qi] = make_float4(bflo(w.x), bfhi(w.x), bflo(w.y), bfhi(w.y)); }
    LAS float* sc = (LAS float*)wlb;
    LAS unsigned char* ring = wlb + S4_RING3;
    float4 o[NQ];
#pragma unroll
    for (int qi = 0; qi < NQ; ++qi) o[qi] = make_float4(0.f, 0.f, 0.f, 0.f);
#define S4_ISSUE(GI, SLOT) do { const int g_ = (GI); const int gg_ = g_ < UG ? g_ : g_ - UG; const unsigned vo_ = g_ < UG ? 0u : 2048u; \
        LAS unsigned char* slot_ = ring + (SLOT) * 4096; \
        if (gg_ < 32) { const char* b_ = (const char*)cbase + ((unsigned)gg_ * (unsigned)(4 * d * 4096) + vo_); \
            _Pragma("unroll") for (int r_ = 0; r_ < 4; ++r_) __builtin_amdgcn_global_load_lds((const unsigned*)(b_ + (unsigned)(r_ * d * 4096)), (LAS unsigned*)(slot_ + r_ * 1024), 16, 0, 2); } \
        else { _Pragma("unroll") for (int r_ = 0; r_ < 4; ++r_) { const int un_ = r_ < NQ ? r_ : NQ - 1; \
            __builtin_amdgcn_global_load_lds((const unsigned*)((const char*)nbase + ((unsigned)(un_ * d * 4096) + vo_)), (LAS unsigned*)(slot_ + r_ * 1024), 16, 0, 0); } } } while (0)
    asm volatile("s_waitcnt vmcnt(0)" ::: "memory");
    S4_ISSUE(0, 0); S4_ISSUE(1, 1); S4_ISSUE(2, 2);
    int cs = 0;
#pragma unroll 1
    for (int gi = 0; gi < NG; ++gi) {
        if (gi + 3 <= NG) asm volatile("s_waitcnt vmcnt(8)" ::: "memory"); else if (gi + 2 <= NG) asm volatile("s_waitcnt vmcnt(4)" ::: "memory"); else asm volatile("s_waitcnt vmcnt(0)" ::: "memory");
        f32x4 vv[4];
#pragma unroll
        for (int r = 0; r < 4; ++r) vv[r] = *(const LAS f32x4*)(ring + (cs * 4 + r) * 1024 + lane * 16);
        asm volatile("s_waitcnt lgkmcnt(0)" ::: "memory");
        if (gi + 3 < NG) S4_ISSUE(gi + 3, cs);
        cs = cs == 2 ? 0 : cs + 1;
        if (gi < UG) {
            float dv[4 * NQ];
#pragma unroll
            for (int r = 0; r < 4; ++r)
#pragma unroll
                for (int qi = 0; qi < NQ; ++qi) dv[r * NQ + qi] = qf[qi].x * vv[r][0] + qf[qi].y * vv[r][1] + qf[qi].z * vv[r][2] + qf[qi].w * vv[r][3];
            const float dsum = row16_reduce_t<NQ>(dv, c);
            {
                const int er = c / NQ, eq = c % NQ, u = 4 * gi + er;
                const bool ok = (u >= eq) && (u <= eq + 128);
                const float w = ok ? fmaf(slope2d, (float)(u - 128 - eq), dsum) : -INFINITY;
                if (c < 4 * NQ) sc[(jl * NQ + eq) * 136 + u] = w;
            }
            if (gi == UG - 1) {
                __builtin_amdgcn_wave_barrier();
#pragma unroll
                for (int hq = 0; hq < 4 * NQ; ++hq) {
                    const float s0 = sc[hq * 136 + lane], s1 = sc[hq * 136 + 64 + lane], s2 = (128 + lane < U) ? sc[hq * 136 + 128 + lane] : -INFINITY;
                    const float m = wave_max(fmaxf(fmaxf(s0, s1), s2));
                    const float p0 = fexp2(s0 - m), p1 = fexp2(s1 - m), p2 = fexp2(s2 - m);
                    const float l = wave_sum(p0 + p1 + p2), inv = frcp(l);
                    sc[hq * 136 + lane] = p0 * inv; sc[hq * 136 + 64 + lane] = p1 * inv; if (128 + lane < 136) sc[hq * 136 + 128 + lane] = (128 + lane < U) ? p2 * inv : 0.f;
                    if (lane == 0) LSE[((size_t)G * M + MP + n * TS + rho + d * (hq % NQ)) * 8 + 4 * jh + hq / NQ] = m + flog2(l);
                }
                __builtin_amdgcn_wave_barrier();
                asm volatile("s_waitcnt vmcnt(0)" ::: "memory");
            }
        } else {
#pragma unroll
            for (int r = 0; r < 4; ++r) {
                const int u = 4 * (gi - UG) + r;
#pragma unroll
                for (int qi = 0; qi < NQ; ++qi) { const float pq = sc[(jl * NQ + qi) * 136 + u];
                    o[qi].x = fmaf(pq, vv[r][0], o[qi].x); o[qi].y = fmaf(pq, vv[r][1], o[qi].y); o[qi].z = fmaf(pq, vv[r][2], o[qi].z); o[qi].w = fmaf(pq, vv[r][3], o[qi].w); }
            }
        }
    }
#undef S4_ISSUE
#pragma unroll
    for (int qi = 0; qi < NQ; ++qi) { v2u w; w.x = pk2(o[qi].x, o[qi].y); w.y = pk2(o[qi].z, o[qi].w);
        *(v2u*)(OG + ((size_t)G * M + MP + n * TS + rho + d * qi) * 512 + (4 * jh + jl) * 64 + 4 * c) = w; }
    __builtin_amdgcn_wave_barrier();
}

__device__ __forceinline__ void attn_sample_item4h(LAS unsigned char* wlb, int n, int jh, int rho, int hw, const bf16* QA, const float* cacheg, const float* kvs_out, bf16* OG, float* LSE, int lane) {
    constexpr int G = 1, d = 4, NQ = 2, wb = 512, U = 128 + NQ;
    constexpr int UG = (U + 7) / 8, NG = 2 * UG;
    static_assert(2 * NQ * 136 * 4 <= S4_RING3 && S4_RING3 + 12 * 1024 <= 16384 && 8 * UG <= 136, "wave LDS region");
    const int hh = lane >> 5, jl = (lane >> 4) & 1, c = lane & 15, hs = 4 * jh + 2 * hw + jl, hd = G * 8 + hs;
    const float* cbase = cacheg + ((size_t)n * wb + rho + d * hh) * 1024 + hs * 64 + 4 * c;
    const float* nbase = kvs_out + ((size_t)n * TS + rho) * 1024 + hs * 64 + 4 * c;
    const float* nb0 = nbase + (size_t)hh * d * 1024;
    const float* nb1 = nbase + (size_t)d * 1024;
    const float slope2d = exp2f(-8.0f * (float)(hd + 1) / 24.0f) * LOG2E * (float)d;
    float4 qf[NQ];
#pragma unroll
    for (int qi = 0; qi < NQ; ++qi) { const v2u w = *(const v2u*)(QA + (size_t)(MP + n * TS + rho + d * qi) * 1536 + hd * 64 + 4 * c);
        qf[qi] = make_float4(bflo(w.x), bfhi(w.x), bflo(w.y), bfhi(w.y)); }
    LAS float* sc = (LAS float*)wlb;
    LAS unsigned char* ring = wlb + S4_RING3;
    float4 o[NQ];
#pragma unroll
    for (int qi = 0; qi < NQ; ++qi) o[qi] = make_float4(0.f, 0.f, 0.f, 0.f);
#define S4H_ISSUE(GI, SLOT) do { const int g_ = (GI); const int gg_ = g_ < UG ? g_ : g_ - UG; const unsigned vo_ = g_ < UG ? 0u : 2048u; \
        LAS unsigned char* slot_ = ring + (SLOT) * 4096; \
        if (gg_ < 16) { const char* b_ = (const char*)cbase + ((unsigned)gg_ * (unsigned)(8 * d * 4096) + vo_); \
            _Pragma("unroll") for (int r_ = 0; r_ < 4; ++r_) __builtin_amdgcn_global_load_lds((const unsigned*)(b_ + (unsigned)(r_ * 2 * d * 4096)), (LAS unsigned*)(slot_ + r_ * 1024), 16, 0, 2); } \
        else { _Pragma("unroll") for (int r_ = 0; r_ < 4; ++r_) \
            __builtin_amdgcn_global_load_lds((const unsigned*)((const char*)(r_ == 0 ? nb0 : nb1) + vo_), (LAS unsigned*)(slot_ + r_ * 1024), 16, 0, 0); } } while (0)
    asm volatile("s_waitcnt vmcnt(0)" ::: "memory");
    S4H_ISSUE(0, 0); S4H_ISSUE(1, 1); S4H_ISSUE(2, 2);
    int cs = 0;
#pragma unroll 1
    for (int gi = 0; gi < NG; ++gi) {
        if (gi + 3 <= NG) asm volatile("s_waitcnt vmcnt(8)" ::: "memory"); else if (gi + 2 <= NG) asm volatile("s_waitcnt vmcnt(4)" ::: "memory"); else asm volatile("s_waitcnt vmcnt(0)" ::: "memory");
        f32x4 vv[4];
#pragma unroll
        for (int r = 0; r < 4; ++r) vv[r] = *(const LAS f32x4*)(ring + (cs * 4 + r) * 1024 + lane * 16);
        asm volatile("s_waitcnt lgkmcnt(0)" ::: "memory");
        if (gi + 3 < NG) S4H_ISSUE(gi + 3, cs);
        cs = cs == 2 ? 0 : cs + 1;
        if (gi < UG) {
            float dv[4 * NQ];
#pragma unroll
            for (int r = 0; r < 4; ++r)
#pragma unroll
                for (int qi = 0; qi < NQ; ++qi) dv[r * NQ + qi] = qf[qi].x * vv[r][0] + qf[qi].y * vv[r][1] + qf[qi].z * vv[r][2] + qf[qi].w * vv[r][3];
            const float dsum = row16_reduce_t<NQ>(dv, c);
            {
                const int er = c / NQ, eq = c % NQ, u = 8 * gi + 2 * er + hh;
                const bool ok = (u >= eq) && (u <= eq + 128);
                const float w = ok ? fmaf(slope2d, (float)(u - 128 - eq), dsum) : -INFINITY;
                if (c < 4 * NQ) sc[(jl * NQ + eq) * 136 + u] = w;
            }
            if (gi == UG - 1) {
                __builtin_amdgcn_wave_barrier();
#pragma unroll
                for (int hq = 0; hq < 2 * NQ; ++hq) {
                    const float s0 = sc[hq * 136 + lane], s1 = sc[hq * 136 + 64 + lane], s2 = (128 + lane < U) ? sc[hq * 136 + 128 + lane] : -INFINITY;
                    const float m = wave_max(fmaxf(fmaxf(s0, s1), s2));
                    const float p0 = fexp2(s0 - m), p1 = fexp2(s1 - m), p2 = fexp2(s2 - m);
                    const float l = wave_sum(p0 + p1 + p2), inv = frcp(l);
                    sc[hq * 136 + lane] = p0 * inv; sc[hq * 136 + 64 + lane] = p1 * inv; if (128 + lane < 136) sc[hq * 136 + 128 + lane] = (128 + lane < U) ? p2 * inv : 0.f;
                    if (lane == 0) LSE[((size_t)G * M + MP + n * TS + rho + d * (hq % NQ)) * 8 + 4 * jh + 2 * hw + hq / NQ] = m + flog2(l);
                }
                __builtin_amdgcn_wave_barrier();
                asm volatile("s_waitcnt vmcnt(0)" ::: "memory");
            }
        } else {
#pragma unroll
            for (int r = 0; r < 4; ++r) {
                const int u = 8 * (gi - UG) + 2 * r + hh;
#pragma unroll
                for (int qi = 0; qi < NQ; ++qi) { const float pq = sc[(jl * NQ + qi) * 136 + u];
                    o[qi].x = fmaf(pq, vv[r][0], o[qi].x); o[qi].y = fmaf(pq, vv[r][1], o[qi].y); o[qi].z = fmaf(pq, vv[r][2], o[qi].z); o[qi].w = fmaf(pq, vv[r][3], o[qi].w); }
            }
        }
    }
#undef S4H_ISSUE
#pragma unroll
    for (int qi = 0; qi < NQ; ++qi) {
        o[qi].x += __shfl_xor(o[qi].x, 32); o[qi].y += __shfl_xor(o[qi].y, 32); o[qi].z += __shfl_xor(o[qi].z, 32); o[qi].w += __shfl_xor(o[qi].w, 32);
        v2u w; w.x = pk2(o[qi].x, o[qi].y); w.y = pk2(o[qi].z, o[qi].w);
        if (hh == 0) *(v2u*)(OG + ((size_t)G * M + MP + n * TS + rho + d * qi) * 512 + hs * 64 + 4 * c) = w; }
    __builtin_amdgcn_wave_barrier();
}

__device__ __forceinline__ void combine_row(int r, int lane, bool act, const bf16* OG, const float* LSE, const bf16* ZA, bf16* OA) {
    if (!act) return;
    const int j = lane >> 3;
    float ls[3], mxl = -INFINITY;
#pragma unroll
    for (int g = 0; g < 3; ++g) { ls[g] = LSE[((size_t)g * M + r) * 8 + j]; mxl = fmaxf(mxl, ls[g]); }
    float wsum = 0.f, acc8[8];
#pragma unroll
    for (int e = 0; e < 8; ++e) acc8[e] = 0.f;
#pragma unroll
    for (int g = 0; g < 3; ++g) { const float wg = fexp2(ls[g] - mxl); wsum += wg;
        const v4u w = *(const v4u*)(OG + ((size_t)g * M + r) * 512 + lane * 8);
        acc8[0] += wg * bflo(w.x); acc8[1] += wg * bfhi(w.x); acc8[2] += wg * bflo(w.y); acc8[3] += wg * bfhi(w.y);
        acc8[4] += wg * bflo(w.z); acc8[5] += wg * bfhi(w.z); acc8[6] += wg * bflo(w.w); acc8[7] += wg * bfhi(w.w); }
    const float inv = frcp(wsum);
    const v4u z = *(const v4u*)(ZA + (size_t)r * 512 + lane * 8);
    v4u o; o.x = pk2(acc8[0] * inv * bflo(z.x), acc8[1] * inv * bfhi(z.x)); o.y = pk2(acc8[2] * inv * bflo(z.y), acc8[3] * inv * bfhi(z.y));
    o.z = pk2(acc8[4] * inv * bflo(z.z), acc8[5] * inv * bfhi(z.z)); o.w = pk2(acc8[6] * inv * bflo(z.w), acc8[7] * inv * bfhi(z.w));
    *(v4u*)(OA + (size_t)r * 1024 + lane * 8) = o;
}
__device__ __forceinline__ void obnorm_item(int r, int h, int lane, const float* OBR, const bf16* ZB, const float* o_gain, bf16* OB) {
    const float* ob = OBR + (size_t)r * 512 + h * 128; const bf16* zb = ZB + (size_t)r * 512 + h * 128;
    const float v0 = ob[lane], v1 = ob[64 + lane];
    const float rstd = frsq(wave_sum(v0 * v0 + v1 * v1) * (1.0f / 128.f) + EPS);
    OB[(size_t)r * 1024 + h * 128 + lane] = (bf16)f2bf(v0 * rstd * o_gain[lane] * bf2f(zb[lane]));
    OB[(size_t)r * 1024 + h * 128 + 64 + lane] = (bf16)f2bf(v1 * rstd * o_gain[64 + lane] * bf2f(zb[64 + lane]));
}
__device__ __forceinline__ void obnorm_item2(int r, int h0, int lane, const float* OBR, const bf16* ZB, const float* o_gain, bf16* OB) {
    const float* ob = OBR + (size_t)r * 512 + h0 * 128; const bf16* zb = ZB + (size_t)r * 512 + h0 * 128;
    float v[4]; bf16 z[4];
#pragma unroll
    for (int k = 0; k < 4; ++k) { v[k] = ob[64 * k + lane]; z[k] = zb[64 * k + lane]; }
    const float g0 = o_gain[lane], g1 = o_gain[64 + lane];
    const float ra = frsq(wave_sum(v[0] * v[0] + v[1] * v[1]) * (1.0f / 128.f) + EPS), rb = frsq(wave_sum(v[2] * v[2] + v[3] * v[3]) * (1.0f / 128.f) + EPS);
    bf16* op = OB + (size_t)r * 1024 + h0 * 128;
    op[lane] = (bf16)f2bf(v[0] * ra * g0 * bf2f(z[0])); op[64 + lane] = (bf16)f2bf(v[1] * ra * g1 * bf2f(z[1]));
    op[128 + lane] = (bf16)f2bf(v[2] * rb * g0 * bf2f(z[2])); op[192 + lane] = (bf16)f2bf(v[3] * rb * g1 * bf2f(z[3]));
}
struct OneUnit {
    int pm, pn;
    __device__ __forceinline__ bool next(int i, pg8::Unit& u) const { if (i > 0) return false; u.pm = pm; u.pn = pn; return true; }
    __device__ __forceinline__ void a_ready(const pg8::Unit&) const {}
    __device__ __forceinline__ void done(const pg8::Unit&) const {}
};
constexpr int N_SGEMM_WG = (MS / 256) * (D / 256);

template <bool SC1 = false> __device__ __forceinline__ void h_rows(int r0, int stride, int rend, int lane, const float* x_p, const float* x_s, const float* norm_gain, const float* ADA, bf16* H) {
    float4 nx[4];
    if (r0 < rend) { const float* xr = r0 < MP ? x_p + (size_t)r0 * D : x_s + (size_t)(r0 - MP) * D;
#pragma unroll
        for (int j = 0; j < 4; ++j) nx[j] = *(const float4*)(xr + 512 * (j >> 1) + 8 * lane + 4 * (j & 1)); }
    for (int r = r0; r < rend; r += stride) {
        const int sq = seq_of_row(r);
        float4 v[4]; float ss = 0.f;
#pragma unroll
        for (int j = 0; j < 4; ++j) v[j] = nx[j];
        const int rn = r + stride;
        if (rn < rend) { const float* xr = rn < MP ? x_p + (size_t)rn * D : x_s + (size_t)(rn - MP) * D;
#pragma unroll
            for (int j = 0; j < 4; ++j) nx[j] = *(const float4*)(xr + 512 * (j >> 1) + 8 * lane + 4 * (j & 1)); }
        float4 gg[4], sh[4], sc[4];
#pragma unroll
        for (int j = 0; j < 4; ++j) { const int c = 512 * (j >> 1) + 8 * lane + 4 * (j & 1); gg[j] = *(const float4*)(norm_gain + c);
            if constexpr (!SC1) { sh[j] = *(const float4*)(ADA + (size_t)sq * 3072 + c); sc[j] = *(const float4*)(ADA + (size_t)sq * 3072 + 1024 + c); } }
        if constexpr (SC1) {
            const float* ab = ADA + (size_t)sq * 3072 + 8 * lane;
            f32x4 t0, t1, t2, t3, t4, t5, t6, t7;
            asm volatile("global_load_dwordx4 %0, %8, off sc1\n\tglobal_load_dwordx4 %1, %8, off offset:16 sc1\n\tglobal_load_dwordx4 %2, %8, off offset:2048 sc1\n\tglobal_load_dwordx4 %3, %8, off offset:2064 sc1\n\t"
                         "global_load_dwordx4 %4, %9, off sc1\n\tglobal_load_dwordx4 %5, %9, off offset:16 sc1\n\tglobal_load_dwordx4 %6, %9, off offset:2048 sc1\n\tglobal_load_dwordx4 %7, %9, off offset:2064 sc1\n\ts_waitcnt vmcnt(0)"
                         : "=&v"(t0), "=&v"(t1), "=&v"(t2), "=&v"(t3), "=&v"(t4), "=&v"(t5), "=&v"(t6), "=&v"(t7) : "v"(ab), "v"(ab + 1024) : "memory");
            sh[0] = make_float4(t0[0], t0[1], t0[2], t0[3]); sh[1] = make_float4(t1[0], t1[1], t1[2], t1[3]); sh[2] = make_float4(t2[0], t2[1], t2[2], t2[3]); sh[3] = make_float4(t3[0], t3[1], t3[2], t3[3]);
            sc[0] = make_float4(t4[0], t4[1], t4[2], t4[3]); sc[1] = make_float4(t5[0], t5[1], t5[2], t5[3]); sc[2] = make_float4(t6[0], t6[1], t6[2], t6[3]); sc[3] = make_float4(t7[0], t7[1], t7[2], t7[3]);
        }
#pragma unroll
        for (int j = 0; j < 4; ++j) ss += v[j].x * v[j].x + v[j].y * v[j].y + v[j].z * v[j].z + v[j].w * v[j].w;
        const float rstd = frsq(wave_sum(ss) * (1.0f / D) + EPS);
#pragma unroll
        for (int jp = 0; jp < 2; ++jp) {
            unsigned w[4];
#pragma unroll
            for (int k = 0; k < 2; ++k) { const int j = 2 * jp + k;
                const float ox = v[j].x * rstd * gg[j].x * (1.f + sc[j].x) + sh[j].x, oy = v[j].y * rstd * gg[j].y * (1.f + sc[j].y) + sh[j].y;
                const float oz = v[j].z * rstd * gg[j].z * (1.f + sc[j].z) + sh[j].z, ow = v[j].w * rstd * gg[j].w * (1.f + sc[j].w) + sh[j].w;
                w[2 * k] = pk2(ox, oy); w[2 * k + 1] = pk2(oz, ow); }
            *(v4u*)(H + (size_t)r * D + 512 * jp + 8 * lane) = (v4u){w[0], w[1], w[2], w[3]};
        }
    }
}
struct RangeOrder {
    pg8::StaticOrder P; int lo, hi;
    __device__ __forceinline__ bool next(int i, pg8::Unit& u) const { return lo + i < hi && P.next(lo + i, u); }
    __device__ __forceinline__ void a_ready(const pg8::Unit&) const {}
    __device__ __forceinline__ void done(const pg8::Unit&) const {}
};
constexpr int N_SIN_WG = (MS / 256) * (NIN / 256);

__device__ __forceinline__ void p0_transpose_pair(const float* W, int K, int N, bf16* WT, LAS float* scr, int itemA, int itemB, int lane) {
    const int nblk = N / 32;
    float wa[32], wb2[32];
    { const int kb = itemA / nblk, nb = itemA % nblk, k0 = 64 * kb, n0 = 32 * nb;
#pragma unroll
      for (int i = 0; i < 32; ++i) wa[i] = W[(size_t)(k0 + 2 * i + (lane >> 5)) * N + n0 + (lane & 31)]; }
    { const int kb = itemB / nblk, nb = itemB % nblk, k0 = 64 * kb, n0 = 32 * nb;
#pragma unroll
      for (int i = 0; i < 32; ++i) wb2[i] = W[(size_t)(k0 + 2 * i + (lane >> 5)) * N + n0 + (lane & 31)]; }
    const int c = lane & 7;
#pragma unroll
    for (int half = 0; half < 2; ++half) {
        const int item = half ? itemB : itemA; const int kb = item / nblk, nb = item % nblk, k0 = 64 * kb, n0 = 32 * nb;
#pragma unroll
        for (int i = 0; i < 32; ++i) scr[(2 * i + (lane >> 5)) * 33 + (lane & 31)] = half ? wb2[i] : wa[i];
        asm volatile("s_waitcnt lgkmcnt(0)" ::: "memory");
        const int pr0 = phys_row(n0);
#pragma unroll
        for (int j = 0; j < 4; ++j) { const int n = (lane >> 3) + 8 * j; const LAS float* sp = scr + (8 * c) * 33 + n;
            v4u o; o.x = pk2(sp[0 * 33], sp[1 * 33]); o.y = pk2(sp[2 * 33], sp[3 * 33]); o.z = pk2(sp[4 * 33], sp[5 * 33]); o.w = pk2(sp[6 * 33], sp[7 * 33]);
            *(v4u*)(WT + (size_t)(pr0 + n) * K + k0 + 8 * c) = o; }
        asm volatile("s_waitcnt lgkmcnt(0)" ::: "memory");
    }
}

#ifndef MK_ONE_LAUNCH
#define MK_ONE_LAUNCH 1
#endif
constexpr int NPHASE = 9;

struct Args { const float* in[19]; float* out; unsigned char* ws; int ph_lo, ph_hi; };

__global__ void __launch_bounds__(NTHR, 2) fwd(Args a) {
    extern __shared__ __attribute__((aligned(16))) unsigned char lds_raw[];
    float* lds = (float*)lds_raw;
    LAS unsigned char* ldsb = (LAS unsigned char*)lds_raw;
    volatile LAS unsigned* MISC = (volatile LAS unsigned*)(ldsb + MISC_OFF);
    const int tid = threadIdx.x, lane = tid & 63, wave = __builtin_amdgcn_readfirstlane(tid >> 6);
    const int gw = blockIdx.x * NWAVES + wave, NGW = gridDim.x * NWAVES;
    const float* x_p = a.in[0]; const float* x_s = a.in[1];
    const float* cache[3] = {a.in[2], a.in[3], a.in[4]};
    const float* state_in = a.in[5]; const float* c_p = a.in[6]; const float* c_s = a.in[7];
    const float* norm_gain = a.in[8]; const float* w_ada = a.in[9]; const float* b_ada = a.in[10]; const float* w_in = a.in[11];
    const float* q_gain = a.in[12]; const float* k_gain = a.in[13]; const float* lb_logits = a.in[14]; const float* o_gain = a.in[15];
    const float* w_ba = a.in[16]; const float* w_bb = a.in[17]; const float* w_out = a.in[18];
    float* out = a.out;
    unsigned* ctl = (unsigned*)(a.ws + WS_CTL);
    float* ADA = (float*)(a.ws + WS_ADA); float* LB = (float*)(a.ws + WS_LB);
    bf16* W1T = (bf16*)(a.ws + WS_W1T); bf16* WAT = (bf16*)(a.ws + WS_WAT); bf16* WOT = (bf16*)(a.ws + WS_WOT);
    bf16* H = (bf16*)(a.ws + WS_H);
    bf16* QA = (bf16*)(a.ws + WS_QA); bf16* KA = (bf16*)(a.ws + WS_KA); bf16* VA = (bf16*)(a.ws + WS_VA); bf16* ZA = (bf16*)(a.ws + WS_ZA);
    bf16* QB = (bf16*)(a.ws + WS_QB); bf16* IB = (bf16*)(a.ws + WS_IB); bf16* ZB = (bf16*)(a.ws + WS_ZB); _Float16* LF = (_Float16*)(a.ws + WS_LF);
    bf16* GA = (bf16*)(a.ws + WS_GA); bf16* GB = (bf16*)(a.ws + WS_GB);
    bf16* OA = (bf16*)(a.ws + WS_OA); bf16* OB = OA + 512; float* OBR = (float*)(a.ws + WS_OBR);
    bf16* MG = (bf16*)(a.ws + WS_MG);
    bf16* OG = (bf16*)(a.ws + WS_OG); float* LSE = (float*)(a.ws + WS_LSE);
    float* DS = (float*)(a.ws + WS_DS); float* DEC = (float*)(a.ws + WS_DEC); bf16* SB = (bf16*)(a.ws + WS_SB);
    const int lo = a.ph_lo, hi = a.ph_hi;
#define IN(k) (lo <= (k) && (k) < hi)
#define BOTH(k) (IN(k) && IN((k) + 1))

    for (int u = tid; u < (LDS_BYTES - RING_BYTES) / 4; u += NTHR) ((LAS unsigned*)(ldsb + RING_BYTES))[u] = 0u;
    __syncthreads();
    XcdBarrier bar; bar.bar = ctl + CW_BAR; bar.x = 0; bar.st = nullptr;
    if (MK_ONE_LAUNCH) bar = xcd_barrier_post(ctl + CW_BAR, MISC + 8);
#define GRID_BAR() do { if (MK_ONE_LAUNCH) xcd_barrier(bar); } while (0)

    if (IN(0)) {
        for (int it = wave * gridDim.x + blockIdx.x; it < 9 * 96; it += NGW) {
            const int cg = it / 9, st = it % 9;
            const int ar = lane & 15, ak = lane >> 4;
            int sq = 16 * st + ar; sq = sq < NSEQ ? sq : NSEQ - 1;
            const float* crow = (sq < NP ? c_p + (size_t)sq * D : c_s + (size_t)(sq - NP) * D) + 4 * ak;
            const float* wcol = w_ada + (size_t)(4 * ak) * 3072 + 32 * cg + 2 * ar;
            f32x4 acc[2];
#pragma unroll
            for (int c = 0; c < 2; ++c) acc[c] = (f32x4){0.f, 0.f, 0.f, 0.f};
            f32x4 av[8]; f32x2 bv[8][4];
#pragma unroll
            for (int s = 0; s < 7; ++s) { av[s] = *(const f32x4*)(crow + 16 * s);
#pragma unroll
                for (int s4 = 0; s4 < 4; ++s4) bv[s][s4] = *(const f32x2*)(wcol + (size_t)(16 * s + s4) * 3072);
                __builtin_amdgcn_sched_barrier(0); }
#pragma unroll 1
            for (int k0 = 0; k0 < D; k0 += 128) {
#pragma unroll
                for (int s = 0; s < 8; ++s) {
                    const int kn = k0 + 16 * s + 112;
                    const int kc = kn < D ? kn : D - 16;
                    av[(s + 7) & 7] = *(const f32x4*)(crow + kc);
#pragma unroll
                    for (int s4 = 0; s4 < 4; ++s4) bv[(s + 7) & 7][s4] = *(const f32x2*)(wcol + (size_t)(kc + s4) * 3072);
#pragma unroll
                    for (int s4 = 0; s4 < 4; ++s4) { const float a1 = siluf_(av[s][s4]);
#pragma unroll
                        for (int c = 0; c < 2; ++c) acc[c] = __builtin_amdgcn_mfma_f32_16x16x4f32(a1, bv[s][s4][c], acc[c], 0, 0, 0); }
                    __builtin_amdgcn_sched_barrier(0);
                }
            }
            const int col = 32 * cg + 2 * ar; const f32x2 bias = *(const f32x2*)(b_ada + col);
#pragma unroll
            for (int e = 0; e < 4; ++e) { const int row = 16 * st + 4 * ak + e;
                if (row < NSEQ) { const f32x2 v = (f32x2){acc[0][e] + bias[0], acc[1][e] + bias[1]}; float* dp = ADA + (size_t)row * 3072 + col;
                    asm volatile("global_store_dwordx2 %0, %1, off sc0 sc1" :: "v"(dp), "v"(v) : "memory"); } }
            asm volatile("s_waitcnt vmcnt(0)" ::: "memory");
            if (lane == 0) (void)xb_add(&ctl[CW_ADA + 64 * st], 1u);
        }
        if (blockIdx.x == 0) {
            const float l0 = lb_logits[tid], l1 = lb_logits[512 + tid];
            const float mx = fmaxf(l0, l1); const float e0 = expf(l0 - mx), e1 = expf(l1 - mx);
            LB[tid] = e0 / (e0 + e1);
        }
        LAS float* scr = (LAS float*)(ldsb + wave * 16384);
        constexpr int I_1 = (D / 64) * (NIN / 32), I_A = (512 / 64) * (D / 32), I_O = (D / 64) * (D / 32);
        const int G0 = (int)gridDim.x, nada = 9 * 96, afull = nada / G0, arem = nada % G0;
        const bool simple = afull >= 7;
        const bool had_ada = wave < afull || (wave == afull && (int)blockIdx.x < arem);
        const int trank = simple ? gw : ((int)blockIdx.x < arem ? (int)blockIdx.x * (7 - afull) + (wave - afull - 1) : arem * (7 - afull) + ((int)blockIdx.x - arem) * (8 - afull) + (wave - afull));
        const int tn = simple ? NGW : arem * (7 - afull) + (G0 - arem) * (8 - afull);
        if (simple || !had_ada) {
            for (int it = trank; it < I_1; it += 2 * tn) {
                const int itb = it + tn;
                if (itb < I_1) p0_transpose_pair(w_in, D, NIN, W1T, scr, it, itb, lane); else p0_transpose_item(w_in, D, NIN, W1T, scr, it, lane);
            }
            for (int it = trank; it < 2 * I_A + I_O; it += tn) {
                int r = it;
                if (r < I_A) { p0_transpose_item(w_ba, 512, D, WAT, scr, r, lane, 1024); continue; } r -= I_A;
                if (r < I_A) { p0_transpose_item(w_bb, 512, D, WAT + 512, scr, r, lane, 1024); continue; } r -= I_A;
                p0_transpose_item(w_out, D, D, WOT, scr, r, lane);
            }
        }
        if (BOTH(0)) {
            if ((int)blockIdx.x < NS) {
                if (tid == 0) { const int st = (NP + (int)blockIdx.x) >> 4; XB_SPIN(xb_ld(&ctl[CW_ADA + 64 * st]) < 96u, bar.bar); }
                __syncthreads();
                h_rows<true>(MP + gw, NGW, M, lane, x_p, x_s, norm_gain, ADA, H);
            }
            GRID_BAR();
        }
    }
    if (IN(1) && !IN(0)) {
        h_rows(MP + gw, NGW, M, lane, x_p, x_s, norm_gain, ADA, H);
        if (BOTH(1)) GRID_BAR();
    }
    if (IN(2)) {
        const int b = (int)blockIdx.x, G = (int)gridDim.x;
        if (b < N_SIN_WG && G > N_SIN_WG) {
            pg8::Gemm g{H, W1T, M, NIN, D}; const OneUnit S{MP / 256 + (b & 3), b >> 2};
            EpiIn E{a.ws, QA, KA, VA, LF, out, q_gain, k_gain, LB};
            pg8::gemm_phase<EpiIn, OneUnit, true, true>(ldsb, g, S, E);
        } else {
            const int nb = G > N_SIN_WG ? G - N_SIN_WG : G, bi = G > N_SIN_WG ? b - N_SIN_WG : b;
            h_rows(bi * NWAVES + wave, nb * NWAVES, MP, lane, x_p, x_s, norm_gain, ADA, H);
        }
        if (BOTH(2)) GRID_BAR();
    }
    if (IN(3)) {
        pg8::Gemm g{H, W1T, MP, NIN, D};
        EpiIn E{a.ws, QA, KA, VA, LF, out, q_gain, k_gain, LB};
        const int cut = ((int)blockIdx.x >> 3) % 9;
        { RangeOrder S; S.P.init(MP, NIN, gridDim.x, (int)blockIdx.x); S.lo = 0; S.hi = cut;
          pg8::gemm_phase<EpiIn, RangeOrder, true, true>(ldsb, g, S, E); }
        __syncthreads();
        {
            LAS float* wl = (LAS float*)(ldsb + wave * 16384); LAS unsigned char* wlb = ldsb + wave * 16384;
            const int task = blockIdx.x;
            if (task < 2 * NS) {
                const int n = task >> 1, jh = task & 1;
                attn_sample_item4<2>(wlb, n, jh, wave, QA, cache[2], out + O_KVS2, OG, LSE, lane);
                attn_sample_item4h(wlb, n, jh, wave & 3, wave >> 2, QA, cache[1], out + O_KVS1, OG, LSE, lane);
                if (wave < 4) attn_sample_item<0>(wl, n * 8 + 4 * jh + wave, QA, cache[0], out + O_KVS0, OG, LSE, lane);
                else hgrn_sample_item(wl, ((n * 4 + 2 * jh + ((wave - 4) >> 1)) << 1) | ((wave - 4) & 1), LF, QB, IB, state_in, OBR, out + O_HS, lane);
                __syncthreads();
                const int r = MP + n * TS + wave;
                combine_row(r, lane, (lane >> 5) == jh, OG, LSE, ZA, OA);
                obnorm_item2(r, 2 * jh, lane, OBR, ZB, o_gain, OB);
                __syncthreads();
            }
        }
        __syncthreads();
        { RangeOrder S; S.P.init(MP, NIN, gridDim.x, (int)blockIdx.x); S.lo = cut; S.hi = 1 << 20;
          pg8::gemm_phase<EpiIn, RangeOrder, true, true>(ldsb, g, S, E); }
        if (BOTH(3)) GRID_BAR();
    }
    if (IN(4)) {
        __syncthreads();
        const int urounds = (int)gridDim.x == 256 ? 4 : (N_ATT_UNITS + (int)gridDim.x - 1) / (int)gridDim.x;
        for (int k = 0; k < urounds; ++k) { const int u = (int)blockIdx.x + k * (int)gridDim.x; if (u < N_ATT_UNITS) attn_prompt_unit(ldsb, u, QA, KA, VA, OG, LSE, tid, wave, lane); }
        { HaPre P; if ((int)blockIdx.x < N_HG_ITEMS) hgrn_phaseA_prefetch(P, blockIdx.x, LF, IB, tid);
          for (int it = blockIdx.x; it < N_HG_ITEMS; it += gridDim.x) { const int itn = it + gridDim.x; hgrn_phaseA_item(ldsb, it, P, itn < N_HG_ITEMS, itn, LF, IB, DS, DEC, tid, wave, lane); } }
        if (BOTH(4) && MK_ONE_LAUNCH) xcd_barrier_arrive(bar);
    }
    if (IN(5)) {
        const bool sg = (int)blockIdx.x < N_SGEMM_WG && (int)gridDim.x > N_SGEMM_WG;
        if (sg) {
            const OneUnit S{MP / 256 + ((int)blockIdx.x >> 2), (int)blockIdx.x & 3};
            pg8::Gemm g{OA, WAT, M, D, D}; EpiG2 E{GA, GB, MG}; pg8::gemm_phase<EpiG2, OneUnit, true, true>(ldsb, g, S, E);
            if (BOTH(4) && MK_ONE_LAUNCH) xcd_barrier_wait(bar);
        } else {
            const int nsb = (int)gridDim.x > N_SGEMM_WG ? (int)gridDim.x - N_SGEMM_WG : (int)gridDim.x, sidx = (int)gridDim.x > N_SGEMM_WG ? (int)blockIdx.x - N_SGEMM_WG : (int)blockIdx.x;
            if ((int)gridDim.x == 256) {
                __syncthreads();
                attn_prompt_unit(ldsb, 4 * 256 + (int)blockIdx.x, QA, KA, VA, OG, LSE, tid, wave, lane);
                attn_prompt_unit(ldsb, 5 * 256 + (int)blockIdx.x, QA, KA, VA, OG, LSE, tid, wave, lane);
                if (sidx < 32) attn_prompt_unit(ldsb, (4 + (sidx >> 4)) * 256 + (sidx & 15), QA, KA, VA, OG, LSE, tid, wave, lane);
            }
            if (BOTH(4) && MK_ONE_LAUNCH) xcd_barrier_wait(bar);
            const int nch = NP * 4 * 128 * 32, cpb = (nch + nsb - 1) / nsb;
            for (int q = sidx * cpb + tid; q < nch && q < (sidx + 1) * cpb; q += NTHR) {
                const int f4 = (q & 31) * 4, i = (q >> 5) & 127, nh = q >> 12;
                f32x4 st = (f32x4){0.f, 0.f, 0.f, 0.f};
#pragma unroll 1
                for (int c0 = 0; c0 < 64; c0 += 16) {
                    v2u dsv[16]; f32x4 dcv[16];
#pragma unroll
                    for (int k = 0; k < 16; ++k) { const size_t it = (size_t)nh * 64 + c0 + k;
                        dsv[k] = *(const v2u*)((const bf16*)DS + (it * 128 + i) * 128 + f4); dcv[k] = *(const f32x4*)(DEC + it * 128 + f4); }
#pragma unroll
                    for (int k = 0; k < 16; ++k) { const size_t it = (size_t)nh * 64 + c0 + k;
                        st = dcv[k] * st + (f32x4){bflo(dsv[k].x), bfhi(dsv[k].x), bflo(dsv[k].y), bfhi(dsv[k].y)};
                        if (c0 + k < 63) { v2u w; w.x = pk2(st[0], st[1]); w.y = pk2(st[2], st[3]); *(v2u*)(SB + ((it + 1) * 128 + i) * 128 + f4) = w; } }
                }
#pragma unroll
                for (int e = 0; e < 4; ++e) out[O_HP + ((size_t)nh * 128 + f4 + e) * 128 + i] = st[e];
            }
        }
        if (BOTH(5)) GRID_BAR();
    }
    if (IN(6)) {
        const bool sg = (int)blockIdx.x < N_SGEMM_WG && (int)gridDim.x > N_SGEMM_WG;
        if (sg) {
            const OneUnit S{MP / 256 + ((int)blockIdx.x >> 2), (int)blockIdx.x & 3};
            pg8::Gemm g{MG, WOT, M, D, D}; EpiY E{out, x_p, x_s, ADA};
            pg8::gemm_phase<EpiY, OneUnit, true, true>(ldsb, g, S, E);
            { HcPre P; hgrn_phaseC_prefetch(P, (int)blockIdx.x, LF, QB, IB, SB, tid);
              hgrn_phaseC_item(ldsb, (int)blockIdx.x, P, false, 0, LF, QB, IB, ZB, SB, o_gain, OB, tid, wave, lane); }
        } else if ((int)gridDim.x == 256) {
            const int sidx = (int)blockIdx.x - N_SGEMM_WG;
            const int nit = sidx < 48 ? 5 : 4, it0 = 16 + (sidx < 48 ? 5 * sidx : 240 + 4 * (sidx - 48));
            { HcPre P; hgrn_phaseC_prefetch(P, it0, LF, QB, IB, SB, tid);
              for (int k = 0; k < nit; ++k) hgrn_phaseC_item(ldsb, it0 + k, P, k + 1 < nit, it0 + k + 1, LF, QB, IB, ZB, SB, o_gain, OB, tid, wave, lane); }
            if (sidx >= 48) for (int r = (sidx - 48) * NWAVES + wave; r < MP; r += 192 * NWAVES) combine_row(r, lane, true, OG, LSE, ZA, OA);
        } else {
            const int nsb = (int)gridDim.x > N_SGEMM_WG ? (int)gridDim.x - N_SGEMM_WG : (int)gridDim.x, sidx = (int)gridDim.x > N_SGEMM_WG ? (int)blockIdx.x - N_SGEMM_WG : (int)blockIdx.x;
            { HcPre P; for (int it = sidx; it < N_HG_ITEMS; it += nsb) { hgrn_phaseC_prefetch(P, it, LF, QB, IB, SB, tid); hgrn_phaseC_item(ldsb, it, P, false, 0, LF, QB, IB, ZB, SB, o_gain, OB, tid, wave, lane); } }
            for (int r = sidx * NWAVES + wave; r < MP; r += nsb * NWAVES) combine_row(r, lane, true, OG, LSE, ZA, OA);
        }
        if (BOTH(6)) GRID_BAR();
    }
    if (IN(7)) {
        { pg8::Gemm g{OA, WAT, MP, D, D}; pg8::StaticOrder S; S.init(MP, D, gridDim.x, (int)blockIdx.x); EpiG2 E{GA, GB, MG};
          pg8::gemm_phase<EpiG2, pg8::StaticOrder, false, true>(ldsb, g, S, E); }
        if (BOTH(7)) GRID_BAR();
    }
    if (IN(8)) {
        pg8::Gemm g{MG, WOT, MP, D, D}; pg8::StaticOrder S; S.init(MP, D, gridDim.x, (int)blockIdx.x); EpiY E{out, x_p, x_s, ADA};
        pg8::gemm_phase<EpiY, pg8::StaticOrder, false, true>(ldsb, g, S, E);
    }
#undef IN
#undef BOTH
}

extern "C" void kernel_launch(void* const* d_in, const int* in_sizes, int n_in, void* d_out, int out_size, void* d_ws, size_t ws_size, hipStream_t stream) {
    static int grid = 0;
    if (grid == 0) {
        if (n_in != 19 || (size_t)out_size != O_END || ws_size < WS_END) { fprintf(stderr, "kernel_launch: unexpected shapes (n_in %d out %d ws %zu)\n", n_in, out_size, ws_size); grid = -1; return; }
        int dev = 0, cus = 0, per_cu = 0;
        if (hipGetDevice(&dev) != hipSuccess || hipDeviceGetAttribute(&cus, hipDeviceAttributeMultiprocessorCount, dev) != hipSuccess) { grid = -1; return; }
        if (hipFuncSetAttribute((const void*)fwd, hipFuncAttributeMaxDynamicSharedMemorySize, LDS_BYTES) != hipSuccess) { fprintf(stderr, "kernel_launch: hipFuncSetAttribute failed\n"); grid = -1; return; }
        if (hipOccupancyMaxActiveBlocksPerMultiprocessor(&per_cu, (const void*)fwd, NTHR, LDS_BYTES) != hipSuccess || per_cu < 1) { fprintf(stderr, "kernel_launch: occupancy query says %d\n", per_cu); }
        (void)hipGetLastError();
        if (cus < 2 * NS) { fprintf(stderr, "kernel_launch: built for a 256-CU device (one workgroup per CU, 256 workgroups); found %d CUs\n", cus); grid = -1; return; }
        grid = 2 * NS;
    }
    if (grid < 0) return;
    hipMemsetAsync((char*)d_ws + WS_CTL, 0, CTL_ZERO_BYTES, stream);
    Args a{};
    for (int i = 0; i < 19; ++i) a.in[i] = (const float*)d_in[i];
    a.out = (float*)d_out; a.ws = (unsigned char*)d_ws;
#if MK_ONE_LAUNCH
    a.ph_lo = 0; a.ph_hi = NPHASE;
    hipLaunchKernelGGL(fwd, dim3(grid), dim3(NTHR), LDS_BYTES, stream, a);
#else
    for (int ph = 0; ph < NPHASE; ++ph) { a.ph_lo = ph; a.ph_hi = ph + 1; hipLaunchKernelGGL(fwd, dim3(grid), dim3(NTHR), LDS_BYTES, stream, a); }
#endif
}
```
